# Optimizing an MI355X kernel written in HIP

```python
import math
import jax, jax.numpy as jnp
from jax import lax
import numpy as np

D_MODEL = 1024
BATCH = 2
SEQ = 8192
DEPTH = 2

PLE_DIM = 256
N_A = DEPTH // 2
N_B = DEPTH - N_A
SB_HEAD_DIM = 64
SB_HEADS = D_MODEL // SB_HEAD_DIM
SB_WIDTH = SB_HEADS * SB_HEAD_DIM
DIFF_QK_DIM = 64
DIFF_V_DIM = 2 * DIFF_QK_DIM
DIFF_HEADS = D_MODEL // DIFF_V_DIM
DIFF_QK_WIDTH = DIFF_HEADS * DIFF_QK_DIM
DIFF_WIDTH = DIFF_HEADS * DIFF_V_DIM
N_BUCKETS = 32
MAX_DISTANCE = 128
BLOCK_Q = 128
EPS = 1e-6
NEG_INF = -1e30

kernel_name = "yoco_stickbreak_diffattn_hybrid"


def rmsnorm(x, g):
    xf = x.astype(jnp.float32)
    y = xf * lax.rsqrt(jnp.mean(xf * xf, axis=-1, keepdims=True) + EPS)
    return (y * g.astype(jnp.float32)).astype(x.dtype)


def t5_bucket(dist):
    n = jnp.maximum(dist, 0)
    max_exact = N_BUCKETS // 2
    nf = jnp.maximum(n, 1).astype(jnp.float32)
    large = max_exact + (jnp.log(nf / max_exact) / math.log(MAX_DISTANCE / max_exact)
                         * (N_BUCKETS - max_exact)).astype(jnp.int32)
    large = jnp.minimum(large, N_BUCKETS - 1)
    return jnp.where(n < max_exact, n, large)


def to_blocks(a):
    b, s, h, d = a.shape
    return a.reshape(b, s // BLOCK_Q, BLOCK_Q, h, d).transpose(1, 0, 2, 3, 4)


def from_blocks(a):
    nb, b, tq, h, d = a.shape
    return a.transpose(1, 0, 2, 3, 4).reshape(b, nb * tq, h, d)


def stick_breaking_attention(q, k, v):
    s_len = k.shape[1]
    scale = 1.0 / math.sqrt(q.shape[-1])
    key_pos = jnp.arange(s_len)

    def block(args):
        qb, t0 = args
        z = jnp.einsum('bqhd,bkhd->bhqk', qb, k) * scale
        q_pos = t0 + jnp.arange(BLOCK_Q)
        past = key_pos[None, :] < q_pos[:, None]
        log_1m = jnp.where(past, jax.nn.log_sigmoid(-z), 0.0)
        rev = lax.cumsum(log_1m, axis=3, reverse=True)
        after = jnp.concatenate([rev[..., 1:], jnp.zeros_like(rev[..., :1])], axis=-1)
        w = jnp.where(past, jnp.exp(jax.nn.log_sigmoid(z) + after), 0.0)
        return jnp.einsum('bhqk,bkhd->bqhd', w, v)

    nb = s_len // BLOCK_Q
    t0s = jnp.arange(nb, dtype=jnp.int32) * BLOCK_Q
    return from_blocks(lax.map(block, (to_blocks(q), t0s)))


def differential_attention(q1, q2, k1, k2, v, lam, rel_bias):
    s_len = k1.shape[1]
    scale = 1.0 / math.sqrt(q1.shape[-1])
    key_pos = jnp.arange(s_len)
    table = rel_bias.astype(jnp.float32)

    def block(args):
        q1b, q2b, t0 = args
        q_pos = t0 + jnp.arange(BLOCK_Q)
        dist = q_pos[:, None] - key_pos[None, :]
        causal = dist >= 0
        bias = jnp.transpose(table[t5_bucket(dist)], (2, 0, 1))
        s1 = jnp.einsum('bqhd,bkhd->bhqk', q1b, k1) * scale + bias
        s2 = jnp.einsum('bqhd,bkhd->bhqk', q2b, k2) * scale + bias
        a1 = jax.nn.softmax(jnp.where(causal, s1, NEG_INF), axis=-1)
        a2 = jax.nn.softmax(jnp.where(causal, s2, NEG_INF), axis=-1)
        return jnp.einsum('bhqk,bkhe->bqhe', a1 - lam * a2, v)

    nb = s_len // BLOCK_Q
    t0s = jnp.arange(nb, dtype=jnp.int32) * BLOCK_Q
    return from_blocks(lax.map(block, (to_blocks(q1), to_blocks(q2), t0s)))


def setup_inputs(seed: int = 0) -> dict:
    key = jax.random.key(seed)
    ks = jax.random.split(key, 18)

    def nrm(k, shape, scale):
        return jax.random.normal(k, shape, jnp.float32) * scale

    def gain(k, shape):
        return 1.0 + 0.02 * jax.random.normal(k, shape, jnp.float32)

    fan = D_MODEL ** -0.5
    return {
        "x": nrm(ks[0], (BATCH, SEQ, D_MODEL), 1.0),
        "p": nrm(ks[1], (DEPTH, BATCH, SEQ, PLE_DIM), 1.0),
        "attn_norm": gain(ks[2], (DEPTH, D_MODEL)),
        "w_in_a": nrm(ks[3], (N_A, D_MODEL, 4 * SB_WIDTH), fan),
        "w_out_a": nrm(ks[4], (N_A, SB_WIDTH, D_MODEL), SB_WIDTH ** -0.5),
        "kv_norm": gain(ks[5], (D_MODEL,)),
        "w_kv": nrm(ks[6], (D_MODEL, 2 * DIFF_QK_WIDTH + DIFF_WIDTH), fan),
        "w_q_b": nrm(ks[7], (N_B, D_MODEL, 2 * DIFF_QK_WIDTH + DIFF_WIDTH), fan),
        "diff_lambda": nrm(ks[8], (N_B, 4, DIFF_QK_DIM), 0.1),
        "diff_subln": gain(ks[9], (N_B, DIFF_V_DIM)),
        "w_out_b": nrm(ks[10], (N_B, DIFF_WIDTH, D_MODEL), DIFF_WIDTH ** -0.5),
        "rel_bias": nrm(ks[11], (N_BUCKETS, DIFF_HEADS), 0.5),
        "ple_norm": gain(ks[12], (DEPTH, D_MODEL)),
        "w_ple_proj": nrm(ks[13], (DEPTH, PLE_DIM, D_MODEL), PLE_DIM ** -0.5),
        "w_ple_gate": nrm(ks[14], (DEPTH, D_MODEL, D_MODEL), fan),
        "final_norm": gain(ks[15], (D_MODEL,)),
    }


def reference(x, p, attn_norm, w_in_a, w_out_a, kv_norm, w_kv, w_q_b, diff_lambda, diff_subln,
              w_out_b, rel_bias, ple_norm, w_ple_proj, w_ple_gate, final_norm):
    b, s, _ = x.shape
    h = x
    shared_k1 = shared_k2 = shared_v = None
    for i in range(DEPTH):
        if i < N_A:
            hn = rmsnorm(h, attn_norm[i])
            proj = hn @ w_in_a[i]
            q, k, v, g = jnp.split(proj, 4, axis=-1)
            q, k, v = (t.reshape(b, s, SB_HEADS, SB_HEAD_DIM).astype(jnp.float32) for t in (q, k, v))
            o = stick_breaking_attention(q, k, v).reshape(b, s, SB_WIDTH).astype(h.dtype)
            h = h + (o * jax.nn.silu(g)) @ w_out_a[i]
        else:
            j = i - N_A
            if i == N_A:
                kv = rmsnorm(h, kv_norm) @ w_kv
                k1, k2, vv = jnp.split(kv, [DIFF_QK_WIDTH, 2 * DIFF_QK_WIDTH], axis=-1)
                shared_k1 = k1.reshape(b, s, DIFF_HEADS, DIFF_QK_DIM).astype(jnp.float32)
                shared_k2 = k2.reshape(b, s, DIFF_HEADS, DIFF_QK_DIM).astype(jnp.float32)
                shared_v = vv.reshape(b, s, DIFF_HEADS, DIFF_V_DIM).astype(jnp.float32)
            hn = rmsnorm(h, attn_norm[i])
            qg = hn @ w_q_b[j]
            q1, q2, g = jnp.split(qg, [DIFF_QK_WIDTH, 2 * DIFF_QK_WIDTH], axis=-1)
            q1 = q1.reshape(b, s, DIFF_HEADS, DIFF_QK_DIM).astype(jnp.float32)
            q2 = q2.reshape(b, s, DIFF_HEADS, DIFF_QK_DIM).astype(jnp.float32)
            lam_init = 0.8 - 0.6 * math.exp(-0.3 * i)
            lp = diff_lambda[j].astype(jnp.float32)
            lam = jnp.exp(jnp.sum(lp[0] * lp[1])) - jnp.exp(jnp.sum(lp[2] * lp[3])) + lam_init
            o = differential_attention(q1, q2, shared_k1, shared_k2, shared_v, lam, rel_bias)
            o = rmsnorm(o, diff_subln[j]) * (1.0 - lam_init)
            o = o.reshape(b, s, DIFF_WIDTH).astype(h.dtype)
            h = h + (o * jax.nn.silu(g)) @ w_out_b[j]
        gate = jax.nn.sigmoid(rmsnorm(h, ple_norm[i]) @ w_ple_gate[i])
        h = h + gate * (p[i] @ w_ple_proj[i])
    return rmsnorm(h, final_norm)
```

```cpp
#include <hip/hip_runtime.h>
#include <cstdio>
#include <cstdint>
#include <cmath>
#define N_LAUNCHES 1
namespace pg8 {
#define PG8_LAS __attribute__((address_space(3)))
typedef unsigned short bf16_t;
typedef short bf16x8 __attribute__((ext_vector_type(8)));
typedef float f32x4 __attribute__((ext_vector_type(4)));
typedef unsigned u32x4 __attribute__((ext_vector_type(4)));
constexpr int BM = 256, BK = 64, HALF = 128, HTB = HALF * BK * 2  , STAGE_BYTES = 8 * HTB, NXCD = 8, WGM = 8;

__host__ __device__ __forceinline__ int lds_byte(int r, int c) { const int st = (r >> 4) * 2 + (c >> 5), rr = r & 15, cc = c & 31, ob = rr * 64 + cc * 2; return st * 1024 + (ob ^ (((ob >> 9) & 1) << 5)); }
__host__ __device__ __forceinline__ void stage_rc(int b, int& R, int& C) { const int st = b / 1024, sb = b % 1024, swz = sb ^ (((sb >> 9) & 1) << 5); R = (st >> 1) * 16 + swz / 64; C = (st & 1) * 32 + (swz % 64) / 2; }
__host__ __device__ __forceinline__ int perm32(int rho) { const int n = rho >> 4, i = rho & 15; return 8 * (i >> 2) + 4 * n + (i & 3); }

struct Unit { int pm, pn; };
struct Gemm { const bf16_t* A; const bf16_t* Bt; int M, N, K; };

struct StaticOrder {
    int nM, nN, nwg, G, c;
    __host__ __device__ void init(int M, int N, int G_, int c_) { nM = M / BM; nN = N / BM; nwg = nM * nN; G = G_; c = c_; }
    __host__ __device__ bool next(int i, Unit& u) const {
        const long L = (long)i * G + c; if (L >= nwg) return false;
        int wgid = (int)L; { const int q = nwg / NXCD, r = nwg % NXCD, xcd = wgid % NXCD, off = wgid / NXCD; wgid = (xcd < r ? xcd * (q + 1) : r * (q + 1) + (xcd - r) * q) + off; }
        const int nig = WGM * nN, gid = wgid / nig, fm = gid * WGM, gsz = (nM - fm) < WGM ? (nM - fm) : WGM;
        u.pm = fm + ((wgid % nig) % gsz); u.pn = (wgid % nig) / gsz; return true;
    }
    __device__ __forceinline__ void a_ready(const Unit&) const {}
    __device__ __forceinline__ void done(const Unit&) const {}
};
__device__ __forceinline__ unsigned cvt_pk_bf16(float lo, float hi) { unsigned r; asm volatile("v_cvt_pk_bf16_f32 %0, %1, %2" : "=v"(r) : "v"(lo), "v"(hi)); return r; }
typedef float f32x2 __attribute__((ext_vector_type(2)));
struct EpiBf16S {
    static constexpr bool PERM = true, AFTER_DRAIN = false;
    bf16_t* O; int ldc; int sc_lo, sc_hi; float scale;
    __device__ __forceinline__ void operator()(const f32x4 (&acc)[2][2][4][2], const Unit& u, int wr, int wc, int fr, int fq) const {
        const int row0 = u.pm * BM + wr * 64 + fr; const int colt = u.pn * BM;
        const float sc = (colt >= sc_lo && colt < sc_hi) ? scale : 1.f;
        const int col0 = colt + wc * 32 + 8 * fq;
#pragma unroll
        for (int ai = 0; ai < 2; ++ai)
#pragma unroll
            for (int m = 0; m < 4; ++m) { bf16_t* rowp = O + (size_t)(row0 + ai * HALF + m * 16) * ldc + col0;
#pragma unroll
                for (int bj = 0; bj < 2; ++bj) { const f32x4 v0 = acc[ai][bj][m][0] * sc, v1 = acc[ai][bj][m][1] * sc;
                    u32x4 w; w.x = cvt_pk_bf16(v0[0], v0[1]); w.y = cvt_pk_bf16(v0[2], v0[3]); w.z = cvt_pk_bf16(v1[0], v1[1]); w.w = cvt_pk_bf16(v1[2], v1[3]);
                    *(u32x4*)(rowp + bj * HALF) = w; } }
    }
};
typedef unsigned u32x2 __attribute__((ext_vector_type(2)));
struct EpiResF32 {
    static constexpr bool PERM = false, AFTER_DRAIN = false;
    const float* base; float* out; int ldc;
    __device__ __forceinline__ void operator()(const f32x4 (&acc)[2][2][4][2], const Unit& u, int wr, int wc, int fr, int fq) const {
        const int col0 = u.pn * BM + wc * 32 + 4 * fq;
#pragma unroll
        for (int ai = 0; ai < 2; ++ai)
#pragma unroll
            for (int m = 0; m < 4; ++m) { const int r = ai * HALF + wr * 64 + m * 16 + fr; const size_t off = (size_t)(u.pm * BM + r) * ldc + col0;
#pragma unroll
                for (int bj = 0; bj < 2; ++bj)
#pragma unroll
                    for (int n = 0; n < 2; ++n) { const f32x4 bs = *(const f32x4*)(base + off + bj * HALF + n * 16); *(f32x4*)(out + off + bj * HALF + n * 16) = bs + acc[ai][bj][m][n]; } }
    }
};
struct EpiBf16NP {
    static constexpr bool PERM = false, AFTER_DRAIN = false;
    bf16_t* O; int ldc;
    __device__ __forceinline__ void operator()(const f32x4 (&acc)[2][2][4][2], const Unit& u, int wr, int wc, int fr, int fq) const {
        const int col0 = u.pn * BM + wc * 32 + 4 * fq;
#pragma unroll
        for (int ai = 0; ai < 2; ++ai)
#pragma unroll
            for (int m = 0; m < 4; ++m) { const int r = ai * HALF + wr * 64 + m * 16 + fr; const size_t off = (size_t)(u.pm * BM + r) * ldc + col0;
#pragma unroll
                for (int bj = 0; bj < 2; ++bj)
#pragma unroll
                    for (int n = 0; n < 2; ++n) { const f32x4 v = acc[ai][bj][m][n]; u32x2 w; w.x = cvt_pk_bf16(v[0], v[1]); w.y = cvt_pk_bf16(v[2], v[3]); *(u32x2*)(O + off + bj * HALF + n * 16) = w; } }
    }
};
__device__ __forceinline__ float bf_lo(unsigned w) { return __builtin_bit_cast(float, w << 16); }
__device__ __forceinline__ float bf_hi(unsigned w) { return __builtin_bit_cast(float, w & 0xffff0000u); }
__device__ __forceinline__ float sigmoidf_(float x) { return __builtin_amdgcn_rcpf(1.f + __builtin_amdgcn_exp2f(-1.4426950408889634f * x)); }
struct EpiGate {
    static constexpr bool PERM = false, AFTER_DRAIN = false;
    float* h; const bf16_t* ple; int ldc;
    __device__ __forceinline__ void operator()(const f32x4 (&acc)[2][2][4][2], const Unit& u, int wr, int wc, int fr, int fq) const {
        const int col0 = u.pn * BM + wc * 32 + 4 * fq;
        size_t off = (size_t)(u.pm * BM + wr * 64 + fr) * ldc + col0;
#pragma unroll
        for (int ai = 0; ai < 2; ++ai) {
#pragma unroll
            for (int m = 0; m < 4; ++m) {
                asm volatile("" : "+v"(off));
                float* hp = h + off; const bf16_t* pp = ple + off;
#pragma unroll
                for (int bj = 0; bj < 2; ++bj)
#pragma unroll
                    for (int n = 0; n < 2; ++n) { const int o2 = bj * HALF + n * 16; const f32x4 a = acc[ai][bj][m][n]; const f32x4 bs = *(const f32x4*)(hp + o2); const u32x2 pw = *(const u32x2*)(pp + o2);
                        f32x4 o; o[0] = bs[0] + sigmoidf_(a[0]) * bf_lo(pw.x); o[1] = bs[1] + sigmoidf_(a[1]) * bf_hi(pw.x); o[2] = bs[2] + sigmoidf_(a[2]) * bf_lo(pw.y); o[3] = bs[3] + sigmoidf_(a[3]) * bf_hi(pw.y);
                        *(f32x4*)(hp + o2) = o; }
                asm volatile("" ::: "memory");
                off += (size_t)16 * ldc; }
            off += (size_t)(HALF - 64) * ldc; }
    }
};
template <class Epi, class Sched, bool ALIGN_EPI = false, bool SP2 = false>
__device__ __forceinline__ void gemm_phase(PG8_LAS unsigned char* lds, const Gemm g, const Sched& S, const Epi& E) {
    int tid_ = threadIdx.x; asm volatile("" : "+v"(tid_));
    const int tid = tid_, wid = __builtin_amdgcn_readfirstlane(tid >> 6), lane = tid & 63, wr = wid >> 2, wc = wid & 3, fr = lane & 15, fq = lane >> 4;
    const int K = g.K, nt = K / BK;
    unsigned voffA[2], voffB[2];
#pragma unroll
    for (int i = 0; i < 2; ++i) { int R, C; stage_rc(tid * 16 + i * 8192, R, C); const int Rb = Epi::PERM ? ((R & ~31) + perm32(R & 31)) : R;
        voffA[i] = (unsigned)(R * K + C) * 2u; voffB[i] = (unsigned)(Rb * K + C) * 2u; }
    const size_t kstep = (size_t)(BK * 2);
    const size_t hstep = (size_t)HALF * K * 2;
    const size_t tstep = 2 * hstep;
    const unsigned ldsw = (unsigned)wid * 1024u;
    const int aoff = lds_byte(wr * 64 + fr, fq * 8), boff = lds_byte(wc * 32 + fr, fq * 8);
#define PG8_SA(b, h) (((b) * 2 + (h)) * HTB)
#define PG8_SB(b, h) ((4 + (b) * 2 + (h)) * HTB)
#define PG8_STAGE(bufoff, gbase, voff) do { _Pragma("unroll") for (int _i = 0; _i < 2; ++_i) \
        __builtin_amdgcn_global_load_lds((const unsigned*)((const char*)(gbase) + (voff)[_i]), (PG8_LAS unsigned*)(lds + (bufoff) + ldsw + _i * 8192), 16, 0, 0); } while (0)
#define PG8_LDA(dst, b, h) do { _Pragma("unroll") for (int m = 0; m < 4; ++m) _Pragma("unroll") for (int k = 0; k < 2; ++k) dst[m][k] = *(const PG8_LAS bf16x8*)(lds + PG8_SA(b, h) + aoff + m * 2048 + k * 1024); } while (0)
#define PG8_LDB(dst, b, h) do { _Pragma("unroll") for (int n = 0; n < 2; ++n) _Pragma("unroll") for (int k = 0; k < 2; ++k) dst[n][k] = *(const PG8_LAS bf16x8*)(lds + PG8_SB(b, h) + boff + n * 2048 + k * 1024); } while (0)
#define PG8_MMA(ai, bj, At, Bt) do { __builtin_amdgcn_s_setprio(1); _Pragma("unroll") for (int m = 0; m < 4; ++m) _Pragma("unroll") for (int n = 0; n < 2; ++n) _Pragma("unroll") for (int k = 0; k < 2; ++k) \
        acc[ai][bj][m][n] = __builtin_amdgcn_mfma_f32_16x16x32_bf16(Bt[n][k], At[m][k], acc[ai][bj][m][n], 0, 0, 0); __builtin_amdgcn_s_setprio(0); } while (0)
#define PG8_WAIT_V(n) asm volatile("s_waitcnt vmcnt(" #n ")" ::: "memory")
#define PG8_WAIT_L(n) asm volatile("s_waitcnt lgkmcnt(" #n ")" ::: "memory")
#define PG8_BAR __builtin_amdgcn_s_barrier()
#define PG8_SCHED __builtin_amdgcn_sched_barrier(0)
    Unit cur, nxt; int ui = 0;
    if (!S.next(0, cur)) return;
    f32x4 acc[2][2][4][2];
#pragma unroll
    for (int a = 0; a < 2; ++a)
#pragma unroll
        for (int b = 0; b < 2; ++b)
#pragma unroll
            for (int m = 0; m < 4; ++m)
#pragma unroll
                for (int n = 0; n < 2; ++n) acc[a][b][m][n] = (f32x4){0.f, 0.f, 0.f, 0.f};
    bf16x8 At[4][2], B0[2][2], B1[2][2];
    const char* cA = (const char*)g.A + (size_t)cur.pm * tstep; const char* cB = (const char*)g.Bt + (size_t)cur.pn * tstep;
    S.a_ready(cur);
    if constexpr (SP2) {
        PG8_STAGE(PG8_SB(0, 0), cB, voffB); PG8_STAGE(PG8_SB(0, 1), cB + hstep, voffB); PG8_STAGE(PG8_SA(0, 0), cA, voffA); PG8_STAGE(PG8_SA(0, 1), cA + hstep, voffA);
        if (wr == 1) PG8_BAR;
        PG8_WAIT_V(2); PG8_BAR;
        PG8_STAGE(PG8_SB(1, 0), cB + kstep, voffB); PG8_STAGE(PG8_SA(1, 0), cA + kstep, voffA); PG8_STAGE(PG8_SB(1, 1), cB + hstep + kstep, voffB);
        PG8_WAIT_V(6); PG8_BAR;
    } else {
        PG8_STAGE(PG8_SB(0, 0), cB, voffB); PG8_STAGE(PG8_SA(0, 0), cA, voffA); PG8_STAGE(PG8_SB(0, 1), cB + hstep, voffB); PG8_STAGE(PG8_SA(0, 1), cA + hstep, voffA);
        if (wr == 1) PG8_BAR;
        PG8_WAIT_V(4); PG8_BAR;
        PG8_STAGE(PG8_SB(1, 0), cB + kstep, voffB); PG8_STAGE(PG8_SA(1, 0), cA + kstep, voffA); PG8_STAGE(PG8_SB(1, 1), cB + hstep + kstep, voffB);
        PG8_WAIT_V(6); PG8_BAR;
    }
    for (;;) {
        const bool has_next = S.next(ui + 1, nxt);
        const char* nA = has_next ? (const char*)g.A + (size_t)nxt.pm * tstep : cA; const char* nB = has_next ? (const char*)g.Bt + (size_t)nxt.pn * tstep : cB;
        for (int t = 0; t < nt; t += 2) {
            const bool last = (t == nt - 2);
            const char* a1 = cA + (size_t)(t + 1) * kstep;
            const char* a2 = last ? nA : cA + (size_t)(t + 2) * kstep; const char* b2 = last ? nB : cB + (size_t)(t + 2) * kstep;
            const char* a3 = a2 + kstep; const char* b3 = b2 + kstep;
            if (last && has_next) S.a_ready(nxt);
            if constexpr (SP2) {
            PG8_LDB(B0, 0, 0); PG8_LDB(B1, 0, 1); PG8_SCHED; PG8_LDA(At, 0, 0); PG8_STAGE(PG8_SA(1, 1), a1 + hstep, voffA);
            PG8_WAIT_V(8); PG8_WAIT_L(0); PG8_BAR; PG8_MMA(0, 0, At, B0); PG8_MMA(0, 1, At, B1); PG8_BAR; PG8_SCHED;
            PG8_LDA(At, 0, 1); PG8_STAGE(PG8_SB(0, 0), b2, voffB); PG8_STAGE(PG8_SB(0, 1), b2 + hstep, voffB); PG8_STAGE(PG8_SA(0, 0), a2, voffA);
            PG8_WAIT_V(8); PG8_WAIT_L(0); PG8_BAR; PG8_MMA(1, 0, At, B0); PG8_MMA(1, 1, At, B1); PG8_BAR; PG8_SCHED;
            PG8_LDB(B0, 1, 0); PG8_LDB(B1, 1, 1); PG8_SCHED; PG8_LDA(At, 1, 0); PG8_STAGE(PG8_SA(0, 1), a2 + hstep, voffA);
            PG8_WAIT_V(8); PG8_WAIT_L(0); PG8_BAR; PG8_MMA(0, 0, At, B0); PG8_MMA(0, 1, At, B1); PG8_BAR; PG8_SCHED;
            PG8_LDA(At, 1, 1); PG8_STAGE(PG8_SB(1, 0), b3, voffB); PG8_STAGE(PG8_SB(1, 1), b3 + hstep, voffB); PG8_STAGE(PG8_SA(1, 0), a3, voffA);
            PG8_WAIT_V(8); PG8_WAIT_L(0); PG8_BAR; PG8_MMA(1, 0, At, B0); PG8_MMA(1, 1, At, B1); PG8_BAR; PG8_SCHED;
            } else {
            PG8_LDB(B0, 0, 0); PG8_SCHED; PG8_LDA(At, 0, 0); PG8_STAGE(PG8_SA(1, 1), a1 + hstep, voffA);
            PG8_WAIT_L(8); PG8_BAR; PG8_WAIT_L(0); PG8_MMA(0, 0, At, B0); PG8_BAR; PG8_SCHED;
            PG8_LDB(B1, 0, 1); PG8_STAGE(PG8_SB(0, 0), b2, voffB);
            PG8_BAR; PG8_WAIT_L(0); PG8_MMA(0, 1, At, B1); PG8_BAR;
            PG8_LDA(At, 0, 1); PG8_STAGE(PG8_SA(0, 0), a2, voffA);
            PG8_BAR; PG8_WAIT_L(0); PG8_MMA(1, 0, At, B0); PG8_BAR; PG8_SCHED;
            PG8_STAGE(PG8_SB(0, 1), b2 + hstep, voffB);
            PG8_WAIT_V(6); PG8_BAR; PG8_MMA(1, 1, At, B1); PG8_BAR;
            PG8_LDB(B0, 1, 0); PG8_SCHED; PG8_LDA(At, 1, 0); PG8_STAGE(PG8_SA(0, 1), a2 + hstep, voffA);
            PG8_WAIT_L(8); PG8_BAR; PG8_WAIT_L(0); PG8_MMA(0, 0, At, B0); PG8_BAR; PG8_SCHED;
            PG8_LDB(B1, 1, 1); PG8_STAGE(PG8_SB(1, 0), b3, voffB);
            PG8_BAR; PG8_WAIT_L(0); PG8_MMA(0, 1, At, B1); PG8_BAR;
            PG8_LDA(At, 1, 1); PG8_STAGE(PG8_SA(1, 0), a3, voffA);
            PG8_BAR; PG8_WAIT_L(0); PG8_MMA(1, 0, At, B0); PG8_BAR; PG8_SCHED;
            PG8_STAGE(PG8_SB(1, 1), b3 + hstep, voffB);
            PG8_WAIT_V(6); PG8_BAR; PG8_MMA(1, 1, At, B1); PG8_BAR;
            }
        }
        if constexpr (ALIGN_EPI) { if (wr == 0) PG8_BAR; }
        if constexpr (!Epi::AFTER_DRAIN) { E(acc, cur, wr, wc, fr, fq); S.done(cur); }
        if (!has_next) break;
#pragma unroll
        for (int a = 0; a < 2; ++a)
#pragma unroll
            for (int b = 0; b < 2; ++b)
#pragma unroll
                for (int m = 0; m < 4; ++m)
#pragma unroll
                    for (int n = 0; n < 2; ++n) acc[a][b][m][n] = (f32x4){0.f, 0.f, 0.f, 0.f};
        cur = nxt; cA = nA; cB = nB; ++ui;
        if constexpr (ALIGN_EPI) { if (wr == 1) PG8_BAR; }
    }
    PG8_WAIT_V(0);
    if constexpr (!ALIGN_EPI) { if (wr == 0) PG8_BAR; }
    PG8_BAR;
    if constexpr (Epi::AFTER_DRAIN) { E.fused(acc, cur, wr, wc, fr, fq, lds, wid, lane); S.done(cur); }
#undef PG8_SA
#undef PG8_SB
#undef PG8_STAGE
#undef PG8_LDA
#undef PG8_LDB
#undef PG8_MMA
#undef PG8_WAIT_V
#undef PG8_WAIT_L
#undef PG8_BAR
#undef PG8_SCHED
}
}
#define GAS __attribute__((address_space(1)))
#define LAS __attribute__((address_space(3)))
typedef unsigned short bf16;
typedef unsigned v4u __attribute__((ext_vector_type(4)));
typedef float f32x4 __attribute__((ext_vector_type(4)));
typedef short bf16x8 __attribute__((ext_vector_type(8)));
typedef GAS unsigned gu32;
typedef GAS unsigned long long gu64;
#define RLX_AGENT __ATOMIC_RELAXED, __HIP_MEMORY_SCOPE_AGENT
#define LDS_WAIT() asm volatile("s_waitcnt lgkmcnt(0)" ::: "memory")
#define VM_WAIT() asm volatile("s_waitcnt vmcnt(0)" ::: "memory")
__device__ __forceinline__ unsigned long long rt() { return __builtin_amdgcn_s_memrealtime(); }
__device__ __forceinline__ unsigned f2bf(float f) { unsigned u = __builtin_bit_cast(unsigned, f); return (u + 0x7fffu + ((u >> 16) & 1u)) >> 16; }
__device__ __forceinline__ unsigned pk2(float lo, float hi) { return f2bf(lo) | (f2bf(hi) << 16); }
#define XB_TMO      128
#define XB_XCNT(j)  (256  + 64 * (j))
#define XB_XSUB(j)  (1280 + 64 * (j))
#define XB_XGEN(j)  (2304 + 64 * (j))
#define XB_TOP      3328
#define XB_TOPGEN   3392
#define XCD_BAR_WORDS 3456
#define XB_SPIN_CAP (1u << 18)

__device__ __forceinline__ unsigned xb_ld(unsigned* p)              { return __hip_atomic_load(p, __ATOMIC_RELAXED, __HIP_MEMORY_SCOPE_AGENT); }
__device__ __forceinline__ unsigned xb_add(unsigned* p, unsigned v) { return __hip_atomic_fetch_add(p, v, __ATOMIC_RELAXED, __HIP_MEMORY_SCOPE_AGENT); }
__device__ __forceinline__ unsigned xb_xcc_id() { return (unsigned)__builtin_amdgcn_s_getreg((3 << 11) | 20) & 0xFu; }
#define XB_SPIN(cond, bar) do { unsigned _sp = 0; while (cond) { __builtin_amdgcn_s_sleep(1); \
    if ((++_sp & 255u) == 0u) { if (xb_ld(&(bar)[XB_TMO])) break; if (_sp > XB_SPIN_CAP) { atomicAdd(&(bar)[XB_TMO], 1u); break; } } } } while (0)

struct XcdBarrier {
    unsigned* bar; unsigned x;
    volatile LAS unsigned* st;
};

__device__ __forceinline__ XcdBarrier xcd_barrier_post(unsigned* bar, volatile LAS unsigned* st) {
    XcdBarrier b; b.bar = bar; b.x = xb_xcc_id(); b.st = st;
    if (threadIdx.x == 0) (void)xb_add(&bar[XB_XCNT(b.x)], 1u);
    return b;
}
__device__ __forceinline__ void xcd_barrier_complete(unsigned* bar, unsigned x, unsigned& nloc, unsigned& nx) {
    const unsigned G = gridDim.x * gridDim.y * gridDim.z;
    unsigned sum, cnt, mine, sp = 0u;
    for (;;) {
        sum = 0u; cnt = 0u; mine = 0u;
#pragma unroll
        for (unsigned j = 0; j < 16; ++j) { const unsigned c = xb_ld(&bar[XB_XCNT(j)]); sum += c; cnt += (c > 0u) ? 1u : 0u; mine = (j == x) ? c : mine; }
        if (sum == G) break;
        __builtin_amdgcn_s_sleep(1);
        if ((++sp & 255u) == 0u) { if (xb_ld(&bar[XB_TMO])) break; if (sp > XB_SPIN_CAP) { atomicAdd(&bar[XB_TMO], 1u); break; } }
    }
    nloc = mine > 0u ? mine : 1u; nx = cnt > 0u ? cnt : 1u;
}

__device__ __forceinline__ void xcd_barrier(const XcdBarrier& b) {
    asm volatile("s_waitcnt vmcnt(0)" ::: "memory");
    __syncthreads();
    if (threadIdx.x == 0) {
        unsigned* bar = b.bar;
        __builtin_amdgcn_s_waitcnt(0);
        unsigned nloc = b.st[0], nx = b.st[1];
        if (nloc == 0u) { xcd_barrier_complete(bar, b.x, nloc, nx); b.st[0] = nloc; b.st[1] = nx; }
        const unsigned old = xb_add(&bar[XB_XSUB(b.x)], 1u);
        const unsigned gen = old / nloc;
        if (old + 1u == (gen + 1u) * nloc) {
            __builtin_amdgcn_fence(__ATOMIC_RELEASE, "agent");
            asm volatile("s_waitcnt vmcnt(0)" ::: "memory");
            const unsigned og = xb_add(&bar[XB_TOP], 1u);
            const unsigned tg = og / nx;
            if (og + 1u == (tg + 1u) * nx) xb_add(&bar[XB_TOPGEN], 1u);
            else XB_SPIN(xb_ld(&bar[XB_TOPGEN]) == tg, bar);
            __builtin_amdgcn_fence(__ATOMIC_ACQUIRE, "agent");
            xb_add(&bar[XB_XGEN(b.x)], 1u);
            asm volatile("s_waitcnt vmcnt(0)" ::: "memory");
        } else {
            XB_SPIN(xb_ld(&bar[XB_XGEN(b.x)]) == gen, bar);
            __builtin_amdgcn_fence(__ATOMIC_ACQUIRE, "agent");
            asm volatile("s_waitcnt vmcnt(0)" ::: "memory");
        }
    }
    __syncthreads();
}

constexpr int NWAVES = 8;
constexpr int BATCH = 2, SEQ = 8192, D = 1024, M = BATCH * SEQ, PLE_DIM = 256;
constexpr int NQ4 = 4096;
constexpr float EPS = 1e-6f;
constexpr float LOG2E = 1.4426950408889634f;
constexpr float C2 = 0.125f * LOG2E;
constexpr float LAM_INIT = 0.35550906759f;

constexpr size_t MiB = 1u << 20;
constexpr size_t WS_CTL = 0, CTL_ZERO_BYTES = 1 * MiB;
constexpr size_t WS_WIN = 2 * MiB, WS_WOA = 10 * MiB, WS_WKVQ = 12 * MiB, WS_WOB = 20 * MiB, WS_WPLE = 22 * MiB, WS_WG = 23 * MiB;
constexpr size_t WS_XCH = 27 * MiB;
constexpr size_t WS_PB = 32 * MiB;
constexpr size_t WS_XN = 48 * MiB;
constexpr size_t WS_OG = 80 * MiB;
constexpr size_t WS_QKVG = 112 * MiB;
constexpr size_t WS_PLE = WS_QKVG;
constexpr size_t WS_END = 240 * MiB;
constexpr int CW_TMO = 0, CW_CODE = 1;
constexpr int CW_BAR = 4096;
constexpr int CW_SEAM = 16384, SEAM_BANK = 128 * 64;

constexpr int RING_OFF = 0, RING_BYTES = 131072;
constexpr int LDSCTL_OFF = RING_BYTES, MISC_OFF = LDSCTL_OFF + 320;
constexpr int LDS_BYTES = 147456;

typedef short s16x4 __attribute__((ext_vector_type(4)));
typedef float f32x16 __attribute__((ext_vector_type(16)));
typedef float f32x2_t __attribute__((ext_vector_type(2)));
typedef __bf16 bf16x2_t __attribute__((ext_vector_type(2)));
typedef short v4i16_t __attribute__((ext_vector_type(4)));
#define DI __device__ __forceinline__
DI unsigned cvtpk(float lo, float hi) { f32x2_t v = {lo, hi}; bf16x2_t b = __builtin_convertvector(v, bf16x2_t); return __builtin_bit_cast(unsigned, b); }
DI float bflo(unsigned w) { return __builtin_bit_cast(float, w << 16); }
DI float bfhi(unsigned w) { return __builtin_bit_cast(float, w & 0xffff0000u); }
DI int crow(int r, int hi) { return (r & 3) + 8 * (r >> 2) + 4 * hi; }
DI s16x4 vtr(LAS const char* p) { return __builtin_bit_cast(s16x4, __builtin_amdgcn_ds_read_tr16_b64_v4i16((LAS v4i16_t*)p)); }
DI float swap_sum(float x) { auto rr = __builtin_amdgcn_permlane32_swap(__float_as_uint(x), __float_as_uint(x), false, false); return __uint_as_float(rr[0]) + __uint_as_float(rr[1]); }
DI float swap_max(float x) { auto rr = __builtin_amdgcn_permlane32_swap(__float_as_uint(x), __float_as_uint(x), false, false); return fmaxf(__uint_as_float(rr[0]), __uint_as_float(rr[1])); }
DI float siluf_(float g) { return g * __builtin_amdgcn_rcpf(1.f + __builtin_amdgcn_exp2f(-LOG2E * g)); }
#define MFMA32(a, b, c) __builtin_amdgcn_mfma_f32_32x32x16_bf16((a), (b), (c), 0, 0, 0)

struct Frame {
    LAS unsigned char* lds;
    volatile LAS unsigned* MISC;
    gu32* ctl;
    int tid, lane, wave;
    int vcu, G;
    const float* in[16]; float* out; unsigned char* ws;
};

DI int fresh(int v) { asm volatile("" : "+v"(v)); return v; }
DI int tid_now() { return fresh((int)threadIdx.x); }
DI int lane_now() { return fresh((int)threadIdx.x) & 63; }
DI float wave_sum(float v) {
#pragma unroll
    for (int o = 1; o < 64; o <<= 1) v += __shfl_xor(v, o);
    return v;
}
DI void p0_transpose_item(const float* W, const float* gain, int K, int N, bf16* WT, int row_off, LAS float* scr, int item, int lane) {
    const int nblk = N / 32, kb = item / nblk, nb = item % nblk, k0 = 64 * kb, n0 = 32 * nb;
#pragma unroll 8
    for (int i = 0; i < 32; ++i) { const int kk = 2 * i + (lane >> 5); const float gk = gain ? gain[k0 + kk] : 1.f; scr[kk * 33 + (lane & 31)] = W[(size_t)(k0 + kk) * N + n0 + (lane & 31)] * gk; }
    LDS_WAIT(); asm volatile("" ::: "memory");
    const int c = lane & 7;
#pragma unroll
    for (int j = 0; j < 4; ++j) { const int n = (lane >> 3) + 8 * j; const LAS float* s = scr + (8 * c) * 33 + n;
        v4u o; o.x = pk2(s[0 * 33], s[1 * 33]); o.y = pk2(s[2 * 33], s[3 * 33]); o.z = pk2(s[4 * 33], s[5 * 33]); o.w = pk2(s[6 * 33], s[7 * 33]);
        *(GAS v4u*)(WT + (size_t)(row_off + n0 + n) * K + k0 + 8 * c) = o; }
    LDS_WAIT(); asm volatile("" ::: "memory");
}
DI void rms_row_to_bf16(int lane, const float* xrow, bf16* orow) {
    const GAS f32x4* xr = (const GAS f32x4*)xrow + lane;
    f32x4 v[4]; float s = 0.f;
#pragma unroll
    for (int j = 0; j < 4; ++j) { v[j] = xr[64 * j]; s += (v[j].x * v[j].x + v[j].y * v[j].y) + (v[j].z * v[j].z + v[j].w * v[j].w); }
    const float rstd = 1.f / sqrtf(wave_sum(s) * (1.f / D) + EPS);
    GAS unsigned long long* o8 = (GAS unsigned long long*)orow + lane;
#pragma unroll
    for (int j = 0; j < 4; ++j) o8[64 * j] = (unsigned long long)pk2(v[j].x * rstd, v[j].y * rstd) | ((unsigned long long)pk2(v[j].z * rstd, v[j].w * rstd) << 32);
}
DI void rms_row_final(int lane, const float* xrow, const float* gain, float* orow) {
    const GAS f32x4* xr = (const GAS f32x4*)xrow + lane; const GAS f32x4* gr = (const GAS f32x4*)gain + lane;
    f32x4 v[4]; float s = 0.f;
#pragma unroll
    for (int j = 0; j < 4; ++j) { v[j] = xr[64 * j]; s += (v[j].x * v[j].x + v[j].y * v[j].y) + (v[j].z * v[j].z + v[j].w * v[j].w); }
    const float rstd = 1.f / sqrtf(wave_sum(s) * (1.f / D) + EPS);
    GAS f32x4* o = (GAS f32x4*)orow + lane;
#pragma unroll
    for (int j = 0; j < 4; ++j) o[64 * j] = (v[j] * rstd) * gr[64 * j];
}

DI void p0_prologue(Frame& F0) {
    Frame F = F0; F.lane = lane_now(); F.tid = tid_now();
    LAS float* scr = (LAS float*)(F.lds + RING_OFF + F.wave * 16384);
    const int gw = F.vcu * NWAVES + F.wave, NGW = F.G * NWAVES;
    unsigned char* ws = F.ws;
    bf16* WIN = (bf16*)(ws + WS_WIN); bf16* WOA = (bf16*)(ws + WS_WOA); bf16* WKVQ = (bf16*)(ws + WS_WKVQ); bf16* WOB = (bf16*)(ws + WS_WOB);
    bf16* WPLE = (bf16*)(ws + WS_WPLE); bf16* WG = (bf16*)(ws + WS_WG);
    constexpr int I_IN = 16 * 128, I_OA = 16 * 32, I_KV = 16 * 64, I_QB = 16 * 64, I_OB = 16 * 32, I_PL = 4 * 32, I_GT = 16 * 32;
    constexpr int NITEMS = I_IN + I_OA + I_KV + I_QB + I_OB + 2 * I_PL + 2 * I_GT;
    for (int it = gw; it < NITEMS; it += NGW) {
        int r = it;
        if (r < I_IN) { p0_transpose_item(F.in[3], F.in[2], D, 4096, WIN, 0, scr, r, F.lane); continue; } r -= I_IN;
        if (r < I_OA) { p0_transpose_item(F.in[4], nullptr, D, D, WOA, 0, scr, r, F.lane); continue; } r -= I_OA;
        if (r < I_KV) { p0_transpose_item(F.in[6], F.in[5], D, 2048, WKVQ, 0, scr, r, F.lane); continue; } r -= I_KV;
        if (r < I_QB) { p0_transpose_item(F.in[7], F.in[2] + D, D, 2048, WKVQ, 2048, scr, r, F.lane); continue; } r -= I_QB;
        if (r < I_OB) { p0_transpose_item(F.in[10], nullptr, D, D, WOB, 0, scr, r, F.lane); continue; } r -= I_OB;
        if (r < I_PL) { p0_transpose_item(F.in[13], nullptr, PLE_DIM, D, WPLE, 0, scr, r, F.lane); continue; } r -= I_PL;
        if (r < I_PL) { p0_transpose_item(F.in[13] + (size_t)PLE_DIM * D, nullptr, PLE_DIM, D, WPLE + (size_t)D * PLE_DIM, 0, scr, r, F.lane); continue; } r -= I_PL;
        if (r < I_GT) { p0_transpose_item(F.in[14], F.in[12], D, D, WG, 0, scr, r, F.lane); continue; } r -= I_GT;
        p0_transpose_item(F.in[14] + (size_t)D * D, F.in[12] + D, D, D, WG + (size_t)D * D, 0, scr, r, F.lane);
    }
    bf16* XN = (bf16*)(ws + WS_XN);
    for (int m = gw; m < M; m += NGW) rms_row_to_bf16(F.lane, F.in[0] + (size_t)m * D, XN + (size_t)m * D);
    const GAS f32x4* pp = (const GAS f32x4*)F.in[1]; GAS v4u* pb = (GAS v4u*)(ws + WS_PB);
    constexpr int NP8 = 2 * M * PLE_DIM / 8;
    for (int i = gw * 64 + F.lane; i < NP8; i += NGW * 64) { const f32x4 a = pp[2 * i], b = pp[2 * i + 1]; v4u o; o.x = pk2(a.x, a.y); o.y = pk2(a.z, a.w); o.z = pk2(b.x, b.y); o.w = pk2(b.z, b.w); pb[i] = o; }
}

constexpr int SB_WLDS = 9216;
DI void sb_task(const bf16* QKVG, bf16* OG, int b, int h, int qt, LAS char* wl, int lane) {
    const int r32 = lane & 31, hi = lane >> 5;
    const size_t rowbase = (size_t)b * SEQ;
    const bf16* Qp = QKVG + (rowbase + 32 * qt + r32) * NQ4 + h * 64 + 8 * hi;
    bf16x8 qf[4];
#pragma unroll
    for (int d0 = 0; d0 < 4; ++d0) qf[d0] = *(const GAS bf16x8*)(Qp + 16 * d0);
    f32x16 oT[2]; oT[0] = f32x16{}; oT[1] = f32x16{};
    float carry = 0.f;
    const unsigned himask = 0u - (unsigned)hi;
    LAS const char* vrd = wl + (4 * hi + ((lane & 15) >> 2)) * 192 + (16 * ((lane >> 4) & 1) + 4 * (lane & 3)) * 2;
    for (int kb = qt; kb >= 0; --kb) {
        const bf16* Kp = QKVG + (rowbase + 32 * kb + r32) * NQ4 + 1024 + h * 64 + 8 * hi;
        bf16x8 kf[4];
#pragma unroll
        for (int d0 = 0; d0 < 4; ++d0) kf[d0] = *(const GAS bf16x8*)(Kp + 16 * d0);
        v4u vv[4];
#pragma unroll
        for (int i = 0; i < 4; ++i) { const int c = lane + 64 * i, row = c >> 3, ch = c & 7; vv[i] = *(const GAS v4u*)(QKVG + (rowbase + 32 * kb + row) * NQ4 + 2048 + h * 64 + ch * 8); }
        f32x16 z = f32x16{};
#pragma unroll
        for (int d0 = 0; d0 < 4; ++d0) z = MFMA32(kf[d0], qf[d0], z);
#pragma unroll
        for (int i = 0; i < 4; ++i) { const int c = lane + 64 * i, row = c >> 3, ch = c & 7; *(LAS v4u*)(wl + row * 192 + ch * 16) = vv[i]; }
        float nl[16], ls[16];
#pragma unroll
        for (int r = 0; r < 16; ++r) { const float zz = z[r]; const float e = __builtin_amdgcn_exp2f(-fabsf(zz)); const float lg = __builtin_amdgcn_logf(1.f + e);
            nl[r] = -(fmaxf(zz, 0.f) + lg); ls[r] = fminf(zz, 0.f) - lg; }
        const bool diag = (kb == qt);
        if (diag) {
#pragma unroll
            for (int r = 0; r < 16; ++r) if (crow(r, hi) >= r32) { nl[r] = 0.f; ls[r] = -INFINITY; }
        }
        float ga[4], gb[4];
#pragma unroll
        for (int g = 0; g < 4; ++g) { const float gs = (nl[4 * g] + nl[4 * g + 1]) + (nl[4 * g + 2] + nl[4 * g + 3]);
            auto rr = __builtin_amdgcn_permlane32_swap(__float_as_uint(gs), __float_as_uint(gs), false, false); ga[g] = __uint_as_float(rr[0]); gb[g] = __uint_as_float(rr[1]); }
        float T[8]; T[7] = 0.f; T[6] = gb[3]; T[5] = T[6] + ga[3]; T[4] = T[5] + gb[2]; T[3] = T[4] + ga[2]; T[2] = T[3] + gb[1]; T[1] = T[2] + ga[1]; T[0] = T[1] + gb[0];
        const float total = T[0] + ga[0];
        float w[16];
#pragma unroll
        for (int g = 0; g < 4; ++g) { const float tsel = __uint_as_float((__float_as_uint(T[2 * g]) & ~himask) | (__float_as_uint(T[2 * g + 1]) & himask));
            const float a3 = carry + tsel, a2 = a3 + nl[4 * g + 3], a1 = a2 + nl[4 * g + 2], a0 = a1 + nl[4 * g + 1];
            w[4 * g + 3] = __builtin_amdgcn_exp2f(ls[4 * g + 3] + a3); w[4 * g + 2] = __builtin_amdgcn_exp2f(ls[4 * g + 2] + a2);
            w[4 * g + 1] = __builtin_amdgcn_exp2f(ls[4 * g + 1] + a1); w[4 * g + 0] = __builtin_amdgcn_exp2f(ls[4 * g + 0] + a0); }
        carry += total;
        asm volatile("" ::: "memory");
#pragma unroll
        for (int s = 0; s < 2; ++s) {
            v4u pw; pw.x = cvtpk(w[8 * s], w[8 * s + 1]); pw.y = cvtpk(w[8 * s + 2], w[8 * s + 3]); pw.z = cvtpk(w[8 * s + 4], w[8 * s + 5]); pw.w = cvtpk(w[8 * s + 6], w[8 * s + 7]);
            const bf16x8 wf = __builtin_bit_cast(bf16x8, pw);
#pragma unroll
            for (int db = 0; db < 2; ++db) {
                const s16x4 lo = vtr(vrd + (16 * s) * 192 + db * 64), hh = vtr(vrd + (16 * s + 8) * 192 + db * 64);
                const bf16x8 vf = (bf16x8){lo[0], lo[1], lo[2], lo[3], hh[0], hh[1], hh[2], hh[3]};
                oT[db] = MFMA32(vf, wf, oT[db]);
            }
        }
        asm volatile("" ::: "memory");
        if (__all(carry < -151.f)) break;
    }
#pragma unroll
    for (int db = 0; db < 2; ++db)
#pragma unroll
        for (int g = 0; g < 4; ++g) *(LAS f32x4*)(wl + r32 * 272 + (32 * db + 8 * g + 4 * hi) * 4) = (f32x4){oT[db][4 * g], oT[db][4 * g + 1], oT[db][4 * g + 2], oT[db][4 * g + 3]};
    asm volatile("" ::: "memory");
#pragma unroll
    for (int i = 0; i < 4; ++i) { const int c = lane + 64 * i, row = c >> 3, ch = c & 7;
        const f32x4 a = *(LAS const f32x4*)(wl + row * 272 + ch * 32), bq = *(LAS const f32x4*)(wl + row * 272 + ch * 32 + 16);
        const v4u gw = *(const GAS v4u*)(QKVG + (rowbase + 32 * qt + row) * NQ4 + 3072 + h * 64 + ch * 8);
        v4u o; o.x = cvtpk(a[0] * siluf_(bflo(gw.x)), a[1] * siluf_(bfhi(gw.x))); o.y = cvtpk(a[2] * siluf_(bflo(gw.y)), a[3] * siluf_(bfhi(gw.y)));
        o.z = cvtpk(bq[0] * siluf_(bflo(gw.z)), bq[1] * siluf_(bfhi(gw.z))); o.w = cvtpk(bq[2] * siluf_(bflo(gw.w)), bq[3] * siluf_(bfhi(gw.w)));
        *(GAS v4u*)(OG + (rowbase + 32 * qt + row) * D + h * 64 + ch * 8) = o; }
    asm volatile("" ::: "memory");
}
DI void sb_phase(Frame& F) {
    const bf16* QKVG = (const bf16*)(F.ws + WS_QKVG); bf16* OG = (bf16*)(F.ws + WS_OG);
    LAS char* wl = (LAS char*)F.lds + RING_OFF + F.wave * SB_WLDS;
    const int gw = F.vcu * NWAVES + F.wave, NGW = F.G * NWAVES;
    constexpr int NTASK = BATCH * 16 * (SEQ / 32);
    const int ln = lane_now();
    for (int t = gw; t < NTASK; t += NGW) { const int qt = t & 255, bh = t >> 8; sb_task(QKVG, OG, bh >> 4, bh & 15, qt, wl, ln); }
}

constexpr int DA_K = 0, DA_V = 16384, DA_TBL = 49152, DA_SUB = DA_TBL + 640 * 4, DA_STG = 53248, DA_WSTG = 8704;
constexpr int DA_THR = 8;
DI int t5_bucket(int n) {
    if (n < 16) return n;
    int b = 16;
    b += (n >= 19); b += (n >= 21); b += (n >= 24); b += (n >= 27); b += (n >= 31); b += (n >= 35); b += (n >= 40); b += (n >= 46);
    b += (n >= 52); b += (n >= 59); b += (n >= 67); b += (n >= 77); b += (n >= 87); b += (n >= 99); b += (n >= 113);
    return b;
}
DI void da_unit(Frame& F, const bf16* KVQG, bf16* OG, float* scr, int b, int h, int qb, float lam) {
    LAS char* lds = (LAS char*)F.lds + RING_OFF;
    const int tid = tid_now(), lane = tid & 63, wid = F.wave, r32 = lane & 31, hi = lane >> 5;
    const size_t rowbase = (size_t)b * SEQ; const int q0 = qb * 256, qw0 = q0 + 32 * wid;
    const float* rb = F.in[11];
    const float c31 = rb[31 * 8 + h] * LOG2E;
    LAS float* tbl = (LAS float*)(lds + DA_TBL); LAS float* subl = (LAS float*)(lds + DA_SUB);
    __syncthreads();
    for (int i = tid; i < 640; i += 512) { const int dist = i - 256; tbl[i] = dist < 0 ? 0.f : rb[t5_bucket(dist) * 8 + h] * LOG2E - c31; }
    if (tid < 128) subl[tid] = F.in[9][tid] * (1.f - LAM_INIT);
    const int NT = 4 * qb + 4;
    LAS const char* kp0 = lds + DA_K + hi * 1024 + r32 * 16;
    LAS const char* vp0 = lds + DA_V + ((lane >> 4) & 1) * 32 + (lane & 3) * 8 + (4 * hi + ((lane & 15) >> 2)) * 64;
    GAS f32x4* myscr = (GAS f32x4*)(scr + ((size_t)(blockIdx.x * NWAVES + wid) * 64 + lane) * 64);
#pragma unroll 1
    for (int mp = 0; mp < 2; ++mp) {
        const int Kcol = mp * 512 + h * 64, Qcol = 2048 + mp * 512 + h * 64, Vcol = 1024 + h * 128;
        bf16x8 qf[4];
        { const bf16* Qp = KVQG + (rowbase + qw0 + r32) * NQ4 + Qcol + 8 * hi;
#pragma unroll
          for (int d0 = 0; d0 < 4; ++d0) qf[d0] = *(const GAS bf16x8*)(Qp + 16 * d0); }
        const bf16* kg = KVQG + (rowbase + (tid & 63)) * NQ4 + Kcol + (tid >> 6) * 8;
        const bf16* vg0 = KVQG + (rowbase + 16 * (wid & 3) + (lane >> 2)) * NQ4 + Vcol + 32 * (wid >> 2) + 8 * (lane & 3);
        const bf16* vg1 = vg0 + 64;
        v4u kreg = *(const GAS v4u*)kg, vreg0 = *(const GAS v4u*)vg0, vreg1 = *(const GAS v4u*)vg1;
        __syncthreads();
        *(LAS v4u*)(lds + DA_K + tid * 16) = kreg; *(LAS v4u*)(lds + DA_V + wid * 1024 + lane * 16) = vreg0; *(LAS v4u*)(lds + DA_V + (wid + 8) * 1024 + lane * 16) = vreg1;
        __syncthreads();
        f32x16 oT[4]; oT[0] = f32x16{}; oT[1] = f32x16{}; oT[2] = f32x16{}; oT[3] = f32x16{};
        float mhat = 0.f, lsum = 0.f;
#pragma unroll 1
        for (int t = 0; t < NT; ++t) {
            const int slot = t & 1;
            if (t + 1 < NT) { const size_t adv = (size_t)(t + 1) * 64 * NQ4; kreg = *(const GAS v4u*)(kg + adv); vreg0 = *(const GAS v4u*)(vg0 + adv); vreg1 = *(const GAS v4u*)(vg1 + adv); }
            const int kv0 = 64 * t;
            if (kv0 <= qw0 + 31) {
                f32x16 c0, c1;
                { const float ini = c31 - mhat; f32x16 negm;
#pragma unroll
                  for (int r = 0; r < 16; ++r) negm[r] = ini;
                  LAS const char* kp = kp0 + slot * 8192;
#pragma unroll
                  for (int d0 = 0; d0 < 4; ++d0) { const bf16x8 b0 = *(LAS const bf16x8*)(kp + d0 * 2048), b1 = *(LAS const bf16x8*)(kp + d0 * 2048 + 512);
                      c0 = MFMA32(b0, qf[d0], d0 == 0 ? negm : c0); c1 = MFMA32(b1, qf[d0], d0 == 0 ? negm : c1); } }
                if (qw0 - (kv0 + 63) < 113) {
                    const int base = (qw0 + r32 - kv0 - 4 * hi) + 256;
#pragma unroll
                    for (int r = 0; r < 16; ++r) { const int i0 = base - ((r & 3) + 8 * (r >> 2)), i1 = i0 - 32;
                        c0[r] = (i0 >= 256) ? c0[r] + tbl[i0 & 1023] : -INFINITY; c1[r] = (i1 >= 256) ? c1[r] + tbl[i1 & 1023] : -INFINITY; }
                }
                float rm = fmaxf(c0[0], c1[0]);
#pragma unroll
                for (int r = 1; r < 16; ++r) rm = fmaxf(rm, fmaxf(c0[r], c1[r]));
                rm = swap_max(rm);
                if (t == 0 || __any(rm > (float)DA_THR)) {
                    const float dl = (t == 0) ? rm : fmaxf(rm, 0.f);
                    mhat += dl; const float f = __builtin_amdgcn_exp2f(-dl); lsum *= f;
#pragma unroll
                    for (int r = 0; r < 16; ++r) { c0[r] -= dl; c1[r] -= dl; }
#pragma unroll
                    for (int db = 0; db < 4; ++db)
#pragma unroll
                        for (int r = 0; r < 16; ++r) oT[db][r] *= f;
                }
                float ps = 0.f;
#pragma unroll
                for (int r = 0; r < 16; ++r) { c0[r] = __builtin_amdgcn_exp2f(c0[r]); c1[r] = __builtin_amdgcn_exp2f(c1[r]); ps += c0[r] + c1[r]; }
                lsum += ps;
                bf16x8 pf[4];
                { v4u pw; pw.x = cvtpk(c0[0], c0[1]); pw.y = cvtpk(c0[2], c0[3]); pw.z = cvtpk(c0[4], c0[5]); pw.w = cvtpk(c0[6], c0[7]); pf[0] = __builtin_bit_cast(bf16x8, pw);
                  pw.x = cvtpk(c0[8], c0[9]); pw.y = cvtpk(c0[10], c0[11]); pw.z = cvtpk(c0[12], c0[13]); pw.w = cvtpk(c0[14], c0[15]); pf[1] = __builtin_bit_cast(bf16x8, pw);
                  pw.x = cvtpk(c1[0], c1[1]); pw.y = cvtpk(c1[2], c1[3]); pw.z = cvtpk(c1[4], c1[5]); pw.w = cvtpk(c1[6], c1[7]); pf[2] = __builtin_bit_cast(bf16x8, pw);
                  pw.x = cvtpk(c1[8], c1[9]); pw.y = cvtpk(c1[10], c1[11]); pw.z = cvtpk(c1[12], c1[13]); pw.w = cvtpk(c1[14], c1[15]); pf[3] = __builtin_bit_cast(bf16x8, pw); }
                LAS const char* vp = vp0 + slot * 16384;
#pragma unroll
                for (int db = 0; db < 4; ++db) {
                    __builtin_amdgcn_sched_barrier(0);
#pragma unroll
                    for (int ks = 0; ks < 4; ++ks) { const s16x4 lo = vtr(vp + db * 4096 + ks * 1024), hh = vtr(vp + db * 4096 + ks * 1024 + 512);
                        const bf16x8 vf = (bf16x8){lo[0], lo[1], lo[2], lo[3], hh[0], hh[1], hh[2], hh[3]};
                        oT[db] = MFMA32(vf, pf[ks], oT[db]); }
                }
                __builtin_amdgcn_sched_barrier(0);
            }
            if (t + 1 < NT) { const int ns = (slot ^ 1);
                *(LAS v4u*)(lds + DA_K + ns * 8192 + tid * 16) = kreg; *(LAS v4u*)(lds + DA_V + ns * 16384 + wid * 1024 + lane * 16) = vreg0; *(LAS v4u*)(lds + DA_V + ns * 16384 + (wid + 8) * 1024 + lane * 16) = vreg1; }
            __syncthreads();
        }
        const float rl = 1.f / swap_sum(lsum);
        if (mp == 0) {
#pragma unroll
            for (int db = 0; db < 4; ++db)
#pragma unroll
                for (int g = 0; g < 4; ++g) myscr[db * 4 + g] = (f32x4){oT[db][4 * g] * rl, oT[db][4 * g + 1] * rl, oT[db][4 * g + 2] * rl, oT[db][4 * g + 3] * rl};
        } else {
            float ss = 0.f;
#pragma unroll
            for (int db = 0; db < 4; ++db)
#pragma unroll
                for (int g = 0; g < 4; ++g) { const f32x4 o1 = myscr[db * 4 + g];
#pragma unroll
                    for (int j = 0; j < 4; ++j) { const float o = o1[j] - lam * (oT[db][4 * g + j] * rl); oT[db][4 * g + j] = o; ss += o * o; } }
            const float rn = 1.f / sqrtf(swap_sum(ss) * (1.f / 128.f) + EPS);
            LAS char* stg = lds + DA_STG + wid * DA_WSTG;
#pragma unroll
            for (int hh = 0; hh < 2; ++hh) {
#pragma unroll
                for (int dd = 0; dd < 2; ++dd)
#pragma unroll
                    for (int g = 0; g < 4; ++g) { const int db = 2 * hh + dd; const f32x4 sg = *(LAS const f32x4*)(subl + 32 * db + 8 * g + 4 * hi);
                        *(LAS f32x4*)(stg + r32 * 272 + (32 * dd + 8 * g + 4 * hi) * 4) = (f32x4){oT[db][4 * g] * rn * sg[0], oT[db][4 * g + 1] * rn * sg[1], oT[db][4 * g + 2] * rn * sg[2], oT[db][4 * g + 3] * rn * sg[3]}; }
                asm volatile("" ::: "memory");
#pragma unroll
                for (int i = 0; i < 4; ++i) { const int c = lane + 64 * i, row = c >> 3, ch = c & 7;
                    const f32x4 a = *(LAS const f32x4*)(stg + row * 272 + ch * 32), bq = *(LAS const f32x4*)(stg + row * 272 + ch * 32 + 16);
                    const v4u gw = *(const GAS v4u*)(KVQG + (rowbase + qw0 + row) * NQ4 + 3072 + h * 128 + 64 * hh + ch * 8);
                    v4u o; o.x = cvtpk(a[0] * siluf_(bflo(gw.x)), a[1] * siluf_(bfhi(gw.x))); o.y = cvtpk(a[2] * siluf_(bflo(gw.y)), a[3] * siluf_(bfhi(gw.y)));
                    o.z = cvtpk(bq[0] * siluf_(bflo(gw.z)), bq[1] * siluf_(bfhi(gw.z))); o.w = cvtpk(bq[2] * siluf_(bflo(gw.w)), bq[3] * siluf_(bfhi(gw.w)));
                    *(GAS v4u*)(OG + (rowbase + qw0 + row) * D + h * 128 + 64 * hh + ch * 8) = o; }
                asm volatile("" ::: "memory");
            }
        }
    }
}
DI void da_phase(Frame& F) {
    const bf16* KVQG = (const bf16*)(F.ws + WS_QKVG); bf16* OG = (bf16*)(F.ws + WS_OG); float* scr = (float*)(F.ws + WS_XN);
    const float* lp = F.in[8];
    float s1 = 0.f, s2 = 0.f;
    for (int i = 0; i < 64; ++i) { s1 += lp[i] * lp[64 + i]; s2 += lp[128 + i] * lp[192 + i]; }
    const float lam = expf(s1) - expf(s2) + LAM_INIT;
    for (int v = F.vcu; v < 256; v += F.G) {
        const int bh = v >> 4, s = v & 15;
        da_unit(F, KVQG, OG, scr, bh >> 3, bh & 7, s, lam);
        da_unit(F, KVQG, OG, scr, bh >> 3, bh & 7, 31 - s, lam);
    }
}

constexpr int NPHASE = 13;
struct Args { const float* in[16]; float* out; unsigned char* ws; int ph_lo, ph_hi, li, pad; };
__global__ void __launch_bounds__(NWAVES * 64, 2) yoco_fwd(Args args) {
    extern __shared__ __attribute__((aligned(16))) unsigned char lds[];
    Frame F;
    F.lds = (LAS unsigned char*)lds;
    F.MISC = (volatile LAS unsigned*)(F.lds + MISC_OFF);
    F.tid = 0; F.lane = 0; F.wave = __builtin_amdgcn_readfirstlane((int)threadIdx.x >> 6);
    F.G = gridDim.x; { const int bx = blockIdx.x; F.vcu = (F.G % 8 == 0) ? (bx % 8) * (F.G / 8) + bx / 8 : bx; }
    unsigned char* ws = args.ws; F.ws = ws; F.out = args.out;
#pragma unroll
    for (int i = 0; i < 16; ++i) F.in[i] = args.in[i];
    F.ctl = (gu32*)(ws + WS_CTL);
    for (int u = threadIdx.x; u < (LDS_BYTES - LDSCTL_OFF) / 4; u += NWAVES * 64) ((LAS unsigned*)(F.lds + LDSCTL_OFF))[u] = 0u;
    __syncthreads();
    const int lo = args.ph_lo, hi = args.ph_hi;
    const bool multi = (hi - lo) > 1;
    XcdBarrier bar; bar.bar = (unsigned*)(F.ctl + CW_BAR) + args.li * XCD_BAR_WORDS; bar.x = 0; bar.st = nullptr;
    if (multi) bar = xcd_barrier_post((unsigned*)(F.ctl + CW_BAR) + args.li * XCD_BAR_WORDS, F.MISC + 8);
#ifndef PH_MASK
#define PH_MASK 0xFFFF
#endif
#define IN(k) (((PH_MASK >> (k)) & 1) && lo <= (k) && (k) < hi)
#define SEAM(k) do { if (IN(k) && IN((k) + 1)) xcd_barrier(bar); } while (0)
    bf16* XN = (bf16*)(ws + WS_XN); bf16* OG = (bf16*)(ws + WS_OG); bf16* QKVG = (bf16*)(ws + WS_QKVG); bf16* PLE = (bf16*)(ws + WS_PLE); bf16* PB = (bf16*)(ws + WS_PB);
    const int gw = F.vcu * NWAVES + F.wave, NGW = F.G * NWAVES;

    if (IN(0)) { p0_prologue(F); } SEAM(0);
    if (IN(1)) {
        pg8::Gemm g{XN, (const bf16*)(ws + WS_WIN), M, NQ4, D}; pg8::StaticOrder S; S.init(M, NQ4, F.G, (int)blockIdx.x);
        pg8::EpiBf16S E{QKVG, NQ4, 0, 1024, C2};
        pg8::gemm_phase<pg8::EpiBf16S, pg8::StaticOrder, true, true>(F.lds + RING_OFF, g, S, E);
    } SEAM(1);
    if (IN(2)) { sb_phase(F); } SEAM(2);
    if (IN(3)) {
        pg8::Gemm g{OG, (const bf16*)(ws + WS_WOA), M, D, D}; pg8::StaticOrder S; S.init(M, D, F.G, (int)blockIdx.x);
        pg8::EpiResF32 E{F.in[0], F.out, D};
        pg8::gemm_phase<pg8::EpiResF32, pg8::StaticOrder, true, true>(F.lds + RING_OFF, g, S, E);
    } SEAM(3);
    if (IN(4)) { const int ln = lane_now(); for (int m = gw; m < M; m += NGW) rms_row_to_bf16(ln, F.out + (size_t)m * D, XN + (size_t)m * D); } SEAM(4);
    if (IN(5)) {
        { pg8::Gemm g{PB, (const bf16*)(ws + WS_WPLE), M, D, PLE_DIM}; pg8::StaticOrder S; S.init(M, D, F.G, (int)blockIdx.x);
          pg8::EpiBf16NP E{PLE, D};
          pg8::gemm_phase<pg8::EpiBf16NP, pg8::StaticOrder, true, true>(F.lds + RING_OFF, g, S, E); }
        { pg8::Gemm g{XN, (const bf16*)(ws + WS_WG), M, D, D}; pg8::StaticOrder S; S.init(M, D, F.G, (int)blockIdx.x);
          pg8::EpiGate E{F.out, PLE, D};
          pg8::gemm_phase<pg8::EpiGate, pg8::StaticOrder, true, true>(F.lds + RING_OFF, g, S, E); }
    } SEAM(5);
    if (IN(6)) { const int ln = lane_now(); for (int m = gw; m < M; m += NGW) rms_row_to_bf16(ln, F.out + (size_t)m * D, XN + (size_t)m * D); } SEAM(6);
    if (IN(7)) {
        pg8::Gemm g{XN, (const bf16*)(ws + WS_WKVQ), M, NQ4, D}; pg8::StaticOrder S; S.init(M, NQ4, F.G, (int)blockIdx.x);
        pg8::EpiBf16S E{QKVG, NQ4, 2048, 3072, C2};
        pg8::gemm_phase<pg8::EpiBf16S, pg8::StaticOrder, true, true>(F.lds + RING_OFF, g, S, E);
    } SEAM(7);
    if (IN(8)) { da_phase(F); } SEAM(8);
    if (IN(9)) {
        pg8::Gemm g{OG, (const bf16*)(ws + WS_WOB), M, D, D}; pg8::StaticOrder S; S.init(M, D, F.G, (int)blockIdx.x);
        pg8::EpiResF32 E{F.out, F.out, D};
        pg8::gemm_phase<pg8::EpiResF32, pg8::StaticOrder, true, true>(F.lds + RING_OFF, g, S, E);
    } SEAM(9);
    if (IN(10)) { const int ln = lane_now(); for (int m = gw; m < M; m += NGW) rms_row_to_bf16(ln, F.out + (size_t)m * D, XN + (size_t)m * D); } SEAM(10);
    if (IN(11)) {
        { pg8::Gemm g{PB + (size_t)M * PLE_DIM, (const bf16*)(ws + WS_WPLE) + (size_t)D * PLE_DIM, M, D, PLE_DIM}; pg8::StaticOrder S; S.init(M, D, F.G, (int)blockIdx.x);
          pg8::EpiBf16NP E{PLE, D};
          pg8::gemm_phase<pg8::EpiBf16NP, pg8::StaticOrder, true, true>(F.lds + RING_OFF, g, S, E); }
        { pg8::Gemm g{XN, (const bf16*)(ws + WS_WG) + (size_t)D * D, M, D, D}; pg8::StaticOrder S; S.init(M, D, F.G, (int)blockIdx.x);
          pg8::EpiGate E{F.out, PLE, D};
          pg8::gemm_phase<pg8::EpiGate, pg8::StaticOrder, true, true>(F.lds + RING_OFF, g, S, E); }
    } SEAM(11);
    if (IN(12)) { const int ln = lane_now(); for (int m = gw; m < M; m += NGW) rms_row_final(ln, F.out + (size_t)m * D, F.in[15], F.out + (size_t)m * D); }
#undef IN
#undef SEAM
}

#ifndef N_LAUNCHES
#define N_LAUNCHES 13
#endif
extern "C" void kernel_launch(void* const* d_in, const int* in_sizes, int n_in, void* d_out, int out_size, void* d_ws, size_t ws_size, hipStream_t stream) {
    static int grid = 0;
    if (grid == 0) {
        if (n_in != 16 || in_sizes[0] != M * D || out_size != M * D || ws_size < WS_END) { fprintf(stderr, "kernel_launch: unexpected shapes (n_in %d, in0 %d, out %d, ws %zu); nothing launched\n", n_in, n_in > 0 ? in_sizes[0] : -1, out_size, ws_size); grid = -1; return; }
        int dev = 0, cus = 0, per_cu = 0;
        if (hipGetDevice(&dev) != hipSuccess || hipDeviceGetAttribute(&cus, hipDeviceAttributeMultiprocessorCount, dev) != hipSuccess) { grid = -1; return; }
        if (hipFuncSetAttribute((const void*)yoco_fwd, hipFuncAttributeMaxDynamicSharedMemorySize, LDS_BYTES) != hipSuccess) { fprintf(stderr, "kernel_launch: hipFuncSetAttribute failed\n"); grid = -1; return; }
        if (hipOccupancyMaxActiveBlocksPerMultiprocessor(&per_cu, (const void*)yoco_fwd, NWAVES * 64, LDS_BYTES) != hipSuccess || per_cu < 1)
            fprintf(stderr, "kernel_launch: note: occupancy query reports %d workgroups per CU\n", per_cu);
        (void)hipGetLastError();
        grid = cus;
    }
    if (grid < 0) return;
    if (hipMemsetAsync((char*)d_ws + WS_CTL, 0, CTL_ZERO_BYTES, stream) != hipSuccess) { fprintf(stderr, "kernel_launch: hipMemsetAsync failed\n"); return; }
    Args a{};
    for (int i = 0; i < 16; ++i) a.in[i] = (const float*)d_in[i];
    a.out = (float*)d_out; a.ws = (unsigned char*)d_ws;
    for (int li = 0; li < N_LAUNCHES; ++li) {
        a.ph_lo = (N_LAUNCHES == 1) ? 0 : li; a.ph_hi = (N_LAUNCHES == 1) ? NPHASE : li + 1; a.li = 0;
        hipLaunchKernelGGL(yoco_fwd, dim3(grid), dim3(NWAVES * 64), LDS_BYTES, stream, a);
        const hipError_t le = hipPeekAtLastError();
        if (le != hipSuccess) { fprintf(stderr, "kernel_launch: launch %d failed: %s\n", li, hipGetErrorName(le)); break; }
    }
}
```

```cpp
#include <hip/hip_runtime.h>
#include <cstdio>
#include <cstdint>
#include <cmath>
#define N_LAUNCHES 1
namespace pg8 {
#define PG8_LAS __attribute__((address_space(3)))
typedef unsigned short bf16_t;
typedef short bf16x8 __attribute__((ext_vector_type(8)));
typedef float f32x4 __attribute__((ext_vector_type(4)));
typedef unsigned u32x4 __attribute__((ext_vector_type(4)));
constexpr int BM = 256, BK = 64, HALF = 128, HTB = HALF * BK * 2  , STAGE_BYTES = 8 * HTB, NXCD = 8, WGM = 8;

__host__ __device__ __forceinline__ int lds_byte(int r, int c) { const int st = (r >> 4) * 2 + (c >> 5), rr = r & 15, cc = c & 31, ob = rr * 64 + cc * 2; return st * 1024 + (ob ^ (((ob >> 9) & 1) << 5)); }
__host__ __device__ __forceinline__ void stage_rc(int b, int& R, int& C) { const int st = b / 1024, sb = b % 1024, swz = sb ^ (((sb >> 9) & 1) << 5); R = (st >> 1) * 16 + swz / 64; C = (st & 1) * 32 + (swz % 64) / 2; }
__host__ __device__ __forceinline__ int perm32(int rho) { const int n = rho >> 4, i = rho & 15; return 8 * (i >> 2) + 4 * n + (i & 3); }

struct Unit { int pm, pn; };
struct Gemm { const bf16_t* A; const bf16_t* Bt; int M, N, K; };

struct StaticOrder {
    int nM, nN, nwg, G, c;
    __host__ __device__ void init(int M, int N, int G_, int c_) { nM = M / BM; nN = N / BM; nwg = nM * nN; G = G_; c = c_; }
    __host__ __device__ bool next(int i, Unit& u) const {
        const long L = (long)i * G + c; if (L >= nwg) return false;
        int wgid = (int)L; { const int q = nwg / NXCD, r = nwg % NXCD, xcd = wgid % NXCD, off = wgid / NXCD; wgid = (xcd < r ? xcd * (q + 1) : r * (q + 1) + (xcd - r) * q) + off; }
        const int nig = WGM * nN, gid = wgid / nig, fm = gid * WGM, gsz = (nM - fm) < WGM ? (nM - fm) : WGM;
        u.pm = fm + ((wgid % nig) % gsz); u.pn = (wgid % nig) / gsz; return true;
    }
    __device__ __forceinline__ void a_ready(const Unit&) const {}
    __device__ __forceinline__ void done(const Unit&) const {}
};
__device__ __forceinline__ unsigned cvt_pk_bf16(float lo, float hi) { unsigned r; asm volatile("v_cvt_pk_bf16_f32 %0, %1, %2" : "=v"(r) : "v"(lo), "v"(hi)); return r; }
typedef float f32x2 __attribute__((ext_vector_type(2)));
struct EpiProj {
    static constexpr bool PERM = true, AFTER_DRAIN = false;
    bf16_t* O; int layer; float scale;
    __device__ __forceinline__ void operator()(const f32x4 (&acc)[2][2][4][2], const Unit& u, int wr, int wc, int fr, int fq) const {
        const int pn = u.pn; int hwl, nh, cs0; size_t sbase; float sc = 1.f;
        if (layer == 0) { const int seg = pn >> 2; sbase = (size_t)seg << 24; cs0 = (pn & 3) * 256; if (seg == 3) { hwl = 10; nh = 1; } else { hwl = 6; nh = 16; } if (seg == 0) sc = scale; }
        else if (pn < 4) { sbase = (size_t)(pn >> 1) << 23; cs0 = (pn & 1) * 256; hwl = 6; nh = 8; }
        else if (pn < 8) { sbase = (size_t)1 << 24; cs0 = (pn - 4) * 256; hwl = 7; nh = 8; }
        else if (pn < 12) { sbase = ((size_t)2 << 24) + ((size_t)((pn - 8) >> 1) << 23); cs0 = (pn & 1) * 256; hwl = 6; nh = 8; sc = scale; }
        else { sbase = (size_t)3 << 24; cs0 = (pn - 12) * 256; hwl = 10; nh = 1; }
        const int row0 = u.pm * BM + wr * 64 + fr; const int b = row0 >> 13;
        const int csl = cs0 + wc * 32 + 8 * fq;
#pragma unroll
        for (int bj = 0; bj < 2; ++bj) { const int cs = csl + bj * HALF, h = cs >> hwl, d = cs & ((1 << hwl) - 1);
            bf16_t* hp = O + sbase + ((((size_t)(b * nh + h)) << 13) << hwl) + d;
#pragma unroll
            for (int ai = 0; ai < 2; ++ai)
#pragma unroll
                for (int m = 0; m < 4; ++m) { const int s = (row0 + ai * HALF + m * 16) & 8191;
                    const f32x4 v0 = acc[ai][bj][m][0] * sc, v1 = acc[ai][bj][m][1] * sc;
                    u32x4 w; w.x = cvt_pk_bf16(v0[0], v0[1]); w.y = cvt_pk_bf16(v0[2], v0[3]); w.z = cvt_pk_bf16(v1[0], v1[1]); w.w = cvt_pk_bf16(v1[2], v1[3]);
                    *(u32x4*)(hp + ((size_t)s << hwl)) = w; } }
    }
};
typedef unsigned u32x2 __attribute__((ext_vector_type(2)));
struct EpiResF32 {
    static constexpr bool PERM = false, AFTER_DRAIN = false;
    const float* base; float* out; int ldc;
    __device__ __forceinline__ void operator()(const f32x4 (&acc)[2][2][4][2], const Unit& u, int wr, int wc, int fr, int fq) const {
        const int col0 = u.pn * BM + wc * 32 + 4 * fq;
#pragma unroll
        for (int ai = 0; ai < 2; ++ai)
#pragma unroll
            for (int m = 0; m < 4; ++m) { const int r = ai * HALF + wr * 64 + m * 16 + fr; const size_t off = (size_t)(u.pm * BM + r) * ldc + col0;
#pragma unroll
                for (int bj = 0; bj < 2; ++bj)
#pragma unroll
                    for (int n = 0; n < 2; ++n) { const f32x4 bs = *(const f32x4*)(base + off + bj * HALF + n * 16); *(f32x4*)(out + off + bj * HALF + n * 16) = bs + acc[ai][bj][m][n]; } }
    }
};
struct EpiBf16NP {
    static constexpr bool PERM = false, AFTER_DRAIN = false;
    bf16_t* O; int ldc;
    __device__ __forceinline__ void operator()(const f32x4 (&acc)[2][2][4][2], const Unit& u, int wr, int wc, int fr, int fq) const {
        const int col0 = u.pn * BM + wc * 32 + 4 * fq;
#pragma unroll
        for (int ai = 0; ai < 2; ++ai)
#pragma unroll
            for (int m = 0; m < 4; ++m) { const int r = ai * HALF + wr * 64 + m * 16 + fr; const size_t off = (size_t)(u.pm * BM + r) * ldc + col0;
#pragma unroll
                for (int bj = 0; bj < 2; ++bj)
#pragma unroll
                    for (int n = 0; n < 2; ++n) { const f32x4 v = acc[ai][bj][m][n]; u32x2 w; w.x = cvt_pk_bf16(v[0], v[1]); w.y = cvt_pk_bf16(v[2], v[3]); *(u32x2*)(O + off + bj * HALF + n * 16) = w; } }
    }
};
__device__ __forceinline__ float bf_lo(unsigned w) { return __builtin_bit_cast(float, w << 16); }
__device__ __forceinline__ float bf_hi(unsigned w) { return __builtin_bit_cast(float, w & 0xffff0000u); }
__device__ __forceinline__ float sigmoidf_(float x) { return __builtin_amdgcn_rcpf(1.f + __builtin_amdgcn_exp2f(-1.4426950408889634f * x)); }
struct EpiGate {
    static constexpr bool PERM = false, AFTER_DRAIN = false;
    float* h; const bf16_t* ple; int ldc;
    __device__ __forceinline__ void operator()(const f32x4 (&acc)[2][2][4][2], const Unit& u, int wr, int wc, int fr, int fq) const {
        const int col0 = u.pn * BM + wc * 32 + 4 * fq;
        size_t off = (size_t)(u.pm * BM + wr * 64 + fr) * ldc + col0;
#pragma unroll
        for (int ai = 0; ai < 2; ++ai) {
#pragma unroll
            for (int m = 0; m < 4; ++m) {
                asm volatile("" : "+v"(off));
                float* hp = h + off; const bf16_t* pp = ple + off;
#pragma unroll
                for (int bj = 0; bj < 2; ++bj)
#pragma unroll
                    for (int n = 0; n < 2; ++n) { const int o2 = bj * HALF + n * 16; const f32x4 a = acc[ai][bj][m][n]; const f32x4 bs = *(const f32x4*)(hp + o2); const u32x2 pw = *(const u32x2*)(pp + o2);
                        f32x4 o; o[0] = bs[0] + sigmoidf_(a[0]) * bf_lo(pw.x); o[1] = bs[1] + sigmoidf_(a[1]) * bf_hi(pw.x); o[2] = bs[2] + sigmoidf_(a[2]) * bf_lo(pw.y); o[3] = bs[3] + sigmoidf_(a[3]) * bf_hi(pw.y);
                        *(f32x4*)(hp + o2) = o; }
                asm volatile("" ::: "memory");
                off += (size_t)16 * ldc; }
            off += (size_t)(HALF - 64) * ldc; }
    }
};
template <class Epi, class Sched, bool ALIGN_EPI = false, bool SP2 = false>
__device__ __forceinline__ void gemm_phase(PG8_LAS unsigned char* lds, const Gemm g, const Sched& S, const Epi& E) {
    int tid_ = threadIdx.x; asm volatile("" : "+v"(tid_));
    const int tid = tid_, wid = __builtin_amdgcn_readfirstlane(tid >> 6), lane = tid & 63, wr = wid >> 2, wc = wid & 3, fr = lane & 15, fq = lane >> 4;
    const int K = g.K, nt = K / BK;
    unsigned voffA[2], voffB[2];
#pragma unroll
    for (int i = 0; i < 2; ++i) { int R, C; stage_rc(tid * 16 + i * 8192, R, C); const int Rb = Epi::PERM ? ((R & ~31) + perm32(R & 31)) : R;
        voffA[i] = (unsigned)(R * K + C) * 2u; voffB[i] = (unsigned)(Rb * K + C) * 2u; }
    const size_t kstep = (size_t)(BK * 2);
    const size_t hstep = (size_t)HALF * K * 2;
    const size_t tstep = 2 * hstep;
    const unsigned ldsw = (unsigned)wid * 1024u;
    const int aoff = lds_byte(wr * 64 + fr, fq * 8), boff = lds_byte(wc * 32 + fr, fq * 8);
#define PG8_SA(b, h) (((b) * 2 + (h)) * HTB)
#define PG8_SB(b, h) ((4 + (b) * 2 + (h)) * HTB)
#define PG8_STAGE(bufoff, gbase, voff) do { _Pragma("unroll") for (int _i = 0; _i < 2; ++_i) \
        __builtin_amdgcn_global_load_lds((const unsigned*)((const char*)(gbase) + (voff)[_i]), (PG8_LAS unsigned*)(lds + (bufoff) + ldsw + _i * 8192), 16, 0, 0); } while (0)
#define PG8_LDA(dst, b, h) do { _Pragma("unroll") for (int m = 0; m < 4; ++m) _Pragma("unroll") for (int k = 0; k < 2; ++k) dst[m][k] = *(const PG8_LAS bf16x8*)(lds + PG8_SA(b, h) + aoff + m * 2048 + k * 1024); } while (0)
#define PG8_LDB(dst, b, h) do { _Pragma("unroll") for (int n = 0; n < 2; ++n) _Pragma("unroll") for (int k = 0; k < 2; ++k) dst[n][k] = *(const PG8_LAS bf16x8*)(lds + PG8_SB(b, h) + boff + n * 2048 + k * 1024); } while (0)
#define PG8_MMA(ai, bj, At, Bt) do { __builtin_amdgcn_s_setprio(1); _Pragma("unroll") for (int m = 0; m < 4; ++m) _Pragma("unroll") for (int n = 0; n < 2; ++n) _Pragma("unroll") for (int k = 0; k < 2; ++k) \
        acc[ai][bj][m][n] = __builtin_amdgcn_mfma_f32_16x16x32_bf16(Bt[n][k], At[m][k], acc[ai][bj][m][n], 0, 0, 0); __builtin_amdgcn_s_setprio(0); } while (0)
#define PG8_WAIT_V(n) asm volatile("s_waitcnt vmcnt(" #n ")" ::: "memory")
#define PG8_WAIT_L(n) asm volatile("s_waitcnt lgkmcnt(" #n ")" ::: "memory")
#define PG8_BAR __builtin_amdgcn_s_barrier()
#define PG8_SCHED __builtin_amdgcn_sched_barrier(0)
    Unit cur, nxt; int ui = 0;
    if (!S.next(0, cur)) return;
    f32x4 acc[2][2][4][2];
#pragma unroll
    for (int a = 0; a < 2; ++a)
#pragma unroll
        for (int b = 0; b < 2; ++b)
#pragma unroll
            for (int m = 0; m < 4; ++m)
#pragma unroll
                for (int n = 0; n < 2; ++n) acc[a][b][m][n] = (f32x4){0.f, 0.f, 0.f, 0.f};
    bf16x8 At[4][2], B0[2][2], B1[2][2];
    const char* cA = (const char*)g.A + (size_t)cur.pm * tstep; const char* cB = (const char*)g.Bt + (size_t)cur.pn * tstep;
    S.a_ready(cur);
    if constexpr (SP2) {
        PG8_STAGE(PG8_SB(0, 0), cB, voffB); PG8_STAGE(PG8_SB(0, 1), cB + hstep, voffB); PG8_STAGE(PG8_SA(0, 0), cA, voffA); PG8_STAGE(PG8_SA(0, 1), cA + hstep, voffA);
        if (wr == 1) PG8_BAR;
        PG8_WAIT_V(2); PG8_BAR;
        PG8_STAGE(PG8_SB(1, 0), cB + kstep, voffB); PG8_STAGE(PG8_SA(1, 0), cA + kstep, voffA); PG8_STAGE(PG8_SB(1, 1), cB + hstep + kstep, voffB);
        PG8_WAIT_V(6); PG8_BAR;
    } else {
        PG8_STAGE(PG8_SB(0, 0), cB, voffB); PG8_STAGE(PG8_SA(0, 0), cA, voffA); PG8_STAGE(PG8_SB(0, 1), cB + hstep, voffB); PG8_STAGE(PG8_SA(0, 1), cA + hstep, voffA);
        if (wr == 1) PG8_BAR;
        PG8_WAIT_V(4); PG8_BAR;
        PG8_STAGE(PG8_SB(1, 0), cB + kstep, voffB); PG8_STAGE(PG8_SA(1, 0), cA + kstep, voffA); PG8_STAGE(PG8_SB(1, 1), cB + hstep + kstep, voffB);
        PG8_WAIT_V(6); PG8_BAR;
    }
    for (;;) {
        const bool has_next = S.next(ui + 1, nxt);
        const char* nA = has_next ? (const char*)g.A + (size_t)nxt.pm * tstep : cA; const char* nB = has_next ? (const char*)g.Bt + (size_t)nxt.pn * tstep : cB;
        for (int t = 0; t < nt; t += 2) {
            const bool last = (t == nt - 2);
            const char* a1 = cA + (size_t)(t + 1) * kstep;
            const char* a2 = last ? nA : cA + (size_t)(t + 2) * kstep; const char* b2 = last ? nB : cB + (size_t)(t + 2) * kstep;
            const char* a3 = a2 + kstep; const char* b3 = b2 + kstep;
            if (last && has_next) S.a_ready(nxt);
            if constexpr (SP2) {
            PG8_LDB(B0, 0, 0); PG8_LDB(B1, 0, 1); PG8_SCHED; PG8_LDA(At, 0, 0); PG8_STAGE(PG8_SA(1, 1), a1 + hstep, voffA);
            PG8_WAIT_V(8); PG8_WAIT_L(0); PG8_BAR; PG8_MMA(0, 0, At, B0); PG8_MMA(0, 1, At, B1); PG8_BAR; PG8_SCHED;
            PG8_LDA(At, 0, 1); PG8_STAGE(PG8_SB(0, 0), b2, voffB); PG8_STAGE(PG8_SB(0, 1), b2 + hstep, voffB); PG8_STAGE(PG8_SA(0, 0), a2, voffA);
            PG8_WAIT_V(8); PG8_WAIT_L(0); PG8_BAR; PG8_MMA(1, 0, At, B0); PG8_MMA(1, 1, At, B1); PG8_BAR; PG8_SCHED;
            PG8_LDB(B0, 1, 0); PG8_LDB(B1, 1, 1); PG8_SCHED; PG8_LDA(At, 1, 0); PG8_STAGE(PG8_SA(0, 1), a2 + hstep, voffA);
            PG8_WAIT_V(8); PG8_WAIT_L(0); PG8_BAR; PG8_MMA(0, 0, At, B0); PG8_MMA(0, 1, At, B1); PG8_BAR; PG8_SCHED;
            PG8_LDA(At, 1, 1); PG8_STAGE(PG8_SB(1, 0), b3, voffB); PG8_STAGE(PG8_SB(1, 1), b3 + hstep, voffB); PG8_STAGE(PG8_SA(1, 0), a3, voffA);
            PG8_WAIT_V(8); PG8_WAIT_L(0); PG8_BAR; PG8_MMA(1, 0, At, B0); PG8_MMA(1, 1, At, B1); PG8_BAR; PG8_SCHED;
            } else {
            PG8_LDB(B0, 0, 0); PG8_SCHED; PG8_LDA(At, 0, 0); PG8_STAGE(PG8_SA(1, 1), a1 + hstep, voffA);
            PG8_WAIT_L(8); PG8_BAR; PG8_WAIT_L(0); PG8_MMA(0, 0, At, B0); PG8_BAR; PG8_SCHED;
            PG8_LDB(B1, 0, 1); PG8_STAGE(PG8_SB(0, 0), b2, voffB);
            PG8_BAR; PG8_WAIT_L(0); PG8_MMA(0, 1, At, B1); PG8_BAR;
            PG8_LDA(At, 0, 1); PG8_STAGE(PG8_SA(0, 0), a2, voffA);
            PG8_BAR; PG8_WAIT_L(0); PG8_MMA(1, 0, At, B0); PG8_BAR; PG8_SCHED;
            PG8_STAGE(PG8_SB(0, 1), b2 + hstep, voffB);
            PG8_WAIT_V(6); PG8_BAR; PG8_MMA(1, 1, At, B1); PG8_BAR;
            PG8_LDB(B0, 1, 0); PG8_SCHED; PG8_LDA(At, 1, 0); PG8_STAGE(PG8_SA(0, 1), a2 + hstep, voffA);
            PG8_WAIT_L(8); PG8_BAR; PG8_WAIT_L(0); PG8_MMA(0, 0, At, B0); PG8_BAR; PG8_SCHED;
            PG8_LDB(B1, 1, 1); PG8_STAGE(PG8_SB(1, 0), b3, voffB);
            PG8_BAR; PG8_WAIT_L(0); PG8_MMA(0, 1, At, B1); PG8_BAR;
            PG8_LDA(At, 1, 1); PG8_STAGE(PG8_SA(1, 0), a3, voffA);
            PG8_BAR; PG8_WAIT_L(0); PG8_MMA(1, 0, At, B0); PG8_BAR; PG8_SCHED;
            PG8_STAGE(PG8_SB(1, 1), b3 + hstep, voffB);
            PG8_WAIT_V(6); PG8_BAR; PG8_MMA(1, 1, At, B1); PG8_BAR;
            }
        }
        if constexpr (ALIGN_EPI) { if (wr == 0) PG8_BAR; }
        if constexpr (!Epi::AFTER_DRAIN) { E(acc, cur, wr, wc, fr, fq); S.done(cur); }
        if (!has_next) break;
#pragma unroll
        for (int a = 0; a < 2; ++a)
#pragma unroll
            for (int b = 0; b < 2; ++b)
#pragma unroll
                for (int m = 0; m < 4; ++m)
#pragma unroll
                    for (int n = 0; n < 2; ++n) acc[a][b][m][n] = (f32x4){0.f, 0.f, 0.f, 0.f};
        cur = nxt; cA = nA; cB = nB; ++ui;
        if constexpr (ALIGN_EPI) { if (wr == 1) PG8_BAR; }
    }
    PG8_WAIT_V(0);
    if constexpr (!ALIGN_EPI) { if (wr == 0) PG8_BAR; }
    PG8_BAR;
    if constexpr (Epi::AFTER_DRAIN) { E.fused(acc, cur, wr, wc, fr, fq, lds, wid, lane); S.done(cur); }
#undef PG8_SA
#undef PG8_SB
#undef PG8_STAGE
#undef PG8_LDA
#undef PG8_LDB
#undef PG8_MMA
#undef PG8_WAIT_V
#undef PG8_WAIT_L
#undef PG8_BAR
#undef PG8_SCHED
}
}
#define GAS __attribute__((address_space(1)))
#define LAS __attribute__((address_space(3)))
typedef unsigned short bf16;
typedef unsigned v4u __attribute__((ext_vector_type(4)));
typedef float f32x4 __attribute__((ext_vector_type(4)));
typedef short bf16x8 __attribute__((ext_vector_type(8)));
typedef GAS unsigned gu32;
typedef GAS unsigned long long gu64;
#define RLX_AGENT __ATOMIC_RELAXED, __HIP_MEMORY_SCOPE_AGENT
#define LDS_WAIT() asm volatile("s_waitcnt lgkmcnt(0)" ::: "memory")
#define VM_WAIT() asm volatile("s_waitcnt vmcnt(0)" ::: "memory")
__device__ __forceinline__ unsigned long long rt() { return __builtin_amdgcn_s_memrealtime(); }
__device__ __forceinline__ unsigned f2bf(float f) { unsigned u = __builtin_bit_cast(unsigned, f); return (u + 0x7fffu + ((u >> 16) & 1u)) >> 16; }
__device__ __forceinline__ unsigned pk2(float lo, float hi) { return f2bf(lo) | (f2bf(hi) << 16); }
#define XB_TMO      128
#define XB_XCNT(j)  (256  + 64 * (j))
#define XB_XSUB(j)  (1280 + 64 * (j))
#define XB_XGEN(j)  (2304 + 64 * (j))
#define XB_TOP      3328
#define XB_TOPGEN   3392
#define XCD_BAR_WORDS 3456
#define XB_SPIN_CAP (1u << 18)

__device__ __forceinline__ unsigned xb_ld(unsigned* p)              { return __hip_atomic_load(p, __ATOMIC_RELAXED, __HIP_MEMORY_SCOPE_AGENT); }
__device__ __forceinline__ unsigned xb_add(unsigned* p, unsigned v) { return __hip_atomic_fetch_add(p, v, __ATOMIC_RELAXED, __HIP_MEMORY_SCOPE_AGENT); }
__device__ __forceinline__ unsigned xb_xcc_id() { return (unsigned)__builtin_amdgcn_s_getreg((3 << 11) | 20) & 0xFu; }
#define XB_SPIN(cond, bar) do { unsigned _sp = 0; while (cond) { __builtin_amdgcn_s_sleep(1); \
    if ((++_sp & 255u) == 0u) { if (xb_ld(&(bar)[XB_TMO])) break; if (_sp > XB_SPIN_CAP) { atomicAdd(&(bar)[XB_TMO], 1u); break; } } } } while (0)

struct XcdBarrier {
    unsigned* bar; unsigned x;
    volatile LAS unsigned* st;
};

__device__ __forceinline__ XcdBarrier xcd_barrier_post(unsigned* bar, volatile LAS unsigned* st) {
    XcdBarrier b; b.bar = bar; b.x = xb_xcc_id(); b.st = st;
    if (threadIdx.x == 0) (void)xb_add(&bar[XB_XCNT(b.x)], 1u);
    return b;
}
__device__ __forceinline__ void xcd_barrier_complete(unsigned* bar, unsigned x, unsigned& nloc, unsigned& nx) {
    const unsigned G = gridDim.x * gridDim.y * gridDim.z;
    unsigned sum, cnt, mine, sp = 0u;
    for (;;) {
        sum = 0u; cnt = 0u; mine = 0u;
#pragma unroll
        for (unsigned j = 0; j < 16; ++j) { const unsigned c = xb_ld(&bar[XB_XCNT(j)]); sum += c; cnt += (c > 0u) ? 1u : 0u; mine = (j == x) ? c : mine; }
        if (sum == G) break;
        __builtin_amdgcn_s_sleep(1);
        if ((++sp & 255u) == 0u) { if (xb_ld(&bar[XB_TMO])) break; if (sp > XB_SPIN_CAP) { atomicAdd(&bar[XB_TMO], 1u); break; } }
    }
    nloc = mine > 0u ? mine : 1u; nx = cnt > 0u ? cnt : 1u;
}

__device__ __forceinline__ void xcd_barrier(const XcdBarrier& b) {
    asm volatile("s_waitcnt vmcnt(0)" ::: "memory");
    __syncthreads();
    if (threadIdx.x == 0) {
        unsigned* bar = b.bar;
        __builtin_amdgcn_s_waitcnt(0);
        unsigned nloc = b.st[0], nx = b.st[1];
        if (nloc == 0u) { xcd_barrier_complete(bar, b.x, nloc, nx); b.st[0] = nloc; b.st[1] = nx; }
        const unsigned old = xb_add(&bar[XB_XSUB(b.x)], 1u);
        const unsigned gen = old / nloc;
        if (old + 1u == (gen + 1u) * nloc) {
            __builtin_amdgcn_fence(__ATOMIC_RELEASE, "agent");
            asm volatile("s_waitcnt vmcnt(0)" ::: "memory");
            const unsigned og = xb_add(&bar[XB_TOP], 1u);
            const unsigned tg = og / nx;
            if (og + 1u == (tg + 1u) * nx) xb_add(&bar[XB_TOPGEN], 1u);
            else XB_SPIN(xb_ld(&bar[XB_TOPGEN]) == tg, bar);
            __builtin_amdgcn_fence(__ATOMIC_ACQUIRE, "agent");
            xb_add(&bar[XB_XGEN(b.x)], 1u);
            asm volatile("s_waitcnt vmcnt(0)" ::: "memory");
        } else {
            XB_SPIN(xb_ld(&bar[XB_XGEN(b.x)]) == gen, bar);
            __builtin_amdgcn_fence(__ATOMIC_ACQUIRE, "agent");
            asm volatile("s_waitcnt vmcnt(0)" ::: "memory");
        }
    }
    __syncthreads();
}

constexpr int NWAVES = 8;
constexpr int BATCH = 2, SEQ = 8192, D = 1024, M = BATCH * SEQ, PLE_DIM = 256;
constexpr int NQ4 = 4096;
constexpr float EPS = 1e-6f;
constexpr float LOG2E = 1.4426950408889634f;
constexpr float C2 = 0.125f * LOG2E;
constexpr float LAM_INIT = 0.35550906759f;

constexpr size_t MiB = 1u << 20;
constexpr size_t WS_CTL = 0, CTL_ZERO_BYTES = 1 * MiB;
constexpr size_t WS_WIN = 2 * MiB, WS_WOA = 10 * MiB, WS_WKVQ = 12 * MiB, WS_WOB = 20 * MiB, WS_WPLE = 22 * MiB, WS_WG = 23 * MiB;
constexpr size_t WS_XCH = 27 * MiB;
constexpr size_t WS_PB = 32 * MiB;
constexpr size_t WS_XN = 48 * MiB;
constexpr size_t WS_OG = 80 * MiB;
constexpr size_t WS_QKVG = 112 * MiB;
constexpr size_t WS_PLE = WS_QKVG;
constexpr size_t WS_END = 240 * MiB;
constexpr int CW_TMO = 0, CW_CODE = 1;
constexpr int CW_BAR = 4096;
constexpr int CW_SEAM = 16384, SEAM_BANK = 128 * 64;

constexpr int RING_OFF = 0, RING_BYTES = 131072;
constexpr int LDS_BYTES = 147456;
constexpr int LDSCTL_OFF = LDS_BYTES - 512, MISC_OFF = LDSCTL_OFF + 320;

typedef short s16x4 __attribute__((ext_vector_type(4)));
typedef float f32x16 __attribute__((ext_vector_type(16)));
typedef float f32x2_t __attribute__((ext_vector_type(2)));
typedef __bf16 bf16x2_t __attribute__((ext_vector_type(2)));
typedef short v4i16_t __attribute__((ext_vector_type(4)));
#define DI __device__ __forceinline__
DI unsigned cvtpk(float lo, float hi) { f32x2_t v = {lo, hi}; bf16x2_t b = __builtin_convertvector(v, bf16x2_t); return __builtin_bit_cast(unsigned, b); }
DI float bflo(unsigned w) { return __builtin_bit_cast(float, w << 16); }
DI float bfhi(unsigned w) { return __builtin_bit_cast(float, w & 0xffff0000u); }
DI int crow(int r, int hi) { return (r & 3) + 8 * (r >> 2) + 4 * hi; }
DI s16x4 vtr(LAS const char* p) { return __builtin_bit_cast(s16x4, __builtin_amdgcn_ds_read_tr16_b64_v4i16((LAS v4i16_t*)p)); }
DI float swap_sum(float x) { auto rr = __builtin_amdgcn_permlane32_swap(__float_as_uint(x), __float_as_uint(x), false, false); return __uint_as_float(rr[0]) + __uint_as_float(rr[1]); }
DI float swap_max(float x) { auto rr = __builtin_amdgcn_permlane32_swap(__float_as_uint(x), __float_as_uint(x), false, false); return fmaxf(__uint_as_float(rr[0]), __uint_as_float(rr[1])); }
DI float siluf_(float g) { return g * __builtin_amdgcn_rcpf(1.f + __builtin_amdgcn_exp2f(-LOG2E * g)); }
#define MFMA32(a, b, c) __builtin_amdgcn_mfma_f32_32x32x16_bf16((a), (b), (c), 0, 0, 0)

struct Frame {
    LAS unsigned char* lds;
    volatile LAS unsigned* MISC;
    gu32* ctl;
    int tid, lane, wave;
    int vcu, G;
    const float* in[16]; float* out; unsigned char* ws;
};

DI int fresh(int v) { asm volatile("" : "+v"(v)); return v; }
DI int tid_now() { return fresh((int)threadIdx.x); }
DI int lane_now() { return fresh((int)threadIdx.x) & 63; }
DI float wave_sum(float v) {
#pragma unroll
    for (int o = 1; o < 64; o <<= 1) v += __shfl_xor(v, o);
    return v;
}
DI void p0_transpose_item(const float* W, const float* gain, int K, int N, bf16* WT, int row_off, LAS float* scr, int item, int lane) {
    const int nblk = N / 32, kb = item / nblk, nb = item % nblk, k0 = 64 * kb, n0 = 32 * nb;
#pragma unroll 8
    for (int i = 0; i < 32; ++i) { const int kk = 2 * i + (lane >> 5); const float gk = gain ? gain[k0 + kk] : 1.f; scr[kk * 33 + (lane & 31)] = W[(size_t)(k0 + kk) * N + n0 + (lane & 31)] * gk; }
    LDS_WAIT(); asm volatile("" ::: "memory");
    const int c = lane & 7;
#pragma unroll
    for (int j = 0; j < 4; ++j) { const int n = (lane >> 3) + 8 * j; const LAS float* s = scr + (8 * c) * 33 + n;
        v4u o; o.x = pk2(s[0 * 33], s[1 * 33]); o.y = pk2(s[2 * 33], s[3 * 33]); o.z = pk2(s[4 * 33], s[5 * 33]); o.w = pk2(s[6 * 33], s[7 * 33]);
        *(GAS v4u*)(WT + (size_t)(row_off + n0 + n) * K + k0 + 8 * c) = o; }
    LDS_WAIT(); asm volatile("" ::: "memory");
}
DI void rms_row_to_bf16(int lane, const float* xrow, bf16* orow) {
    const GAS f32x4* xr = (const GAS f32x4*)xrow + lane;
    f32x4 v[4]; float s = 0.f;
#pragma unroll
    for (int j = 0; j < 4; ++j) { v[j] = xr[64 * j]; s += (v[j].x * v[j].x + v[j].y * v[j].y) + (v[j].z * v[j].z + v[j].w * v[j].w); }
    const float rstd = 1.f / sqrtf(wave_sum(s) * (1.f / D) + EPS);
    GAS unsigned long long* o8 = (GAS unsigned long long*)orow + lane;
#pragma unroll
    for (int j = 0; j < 4; ++j) o8[64 * j] = (unsigned long long)pk2(v[j].x * rstd, v[j].y * rstd) | ((unsigned long long)pk2(v[j].z * rstd, v[j].w * rstd) << 32);
}
DI void rms_row_final(int lane, const float* xrow, const float* gain, float* orow) {
    const GAS f32x4* xr = (const GAS f32x4*)xrow + lane; const GAS f32x4* gr = (const GAS f32x4*)gain + lane;
    f32x4 v[4]; float s = 0.f;
#pragma unroll
    for (int j = 0; j < 4; ++j) { v[j] = xr[64 * j]; s += (v[j].x * v[j].x + v[j].y * v[j].y) + (v[j].z * v[j].z + v[j].w * v[j].w); }
    const float rstd = 1.f / sqrtf(wave_sum(s) * (1.f / D) + EPS);
    GAS f32x4* o = (GAS f32x4*)orow + lane;
#pragma unroll
    for (int j = 0; j < 4; ++j) o[64 * j] = (v[j] * rstd) * gr[64 * j];
}

DI void p0_prologue(Frame& F0) {
    Frame F = F0; F.lane = lane_now(); F.tid = tid_now();
    LAS float* scr = (LAS float*)(F.lds + RING_OFF + F.wave * 16384);
    const int gw = F.vcu * NWAVES + F.wave, NGW = F.G * NWAVES;
    unsigned char* ws = F.ws;
    bf16* WIN = (bf16*)(ws + WS_WIN); bf16* WOA = (bf16*)(ws + WS_WOA); bf16* WKVQ = (bf16*)(ws + WS_WKVQ); bf16* WOB = (bf16*)(ws + WS_WOB);
    bf16* WPLE = (bf16*)(ws + WS_WPLE); bf16* WG = (bf16*)(ws + WS_WG);
    constexpr int I_IN = 16 * 128, I_OA = 16 * 32, I_KV = 16 * 64, I_QB = 16 * 64, I_OB = 16 * 32, I_PL = 4 * 32, I_GT = 16 * 32;
    constexpr int NITEMS = I_IN + I_OA + I_KV + I_QB + I_OB + 2 * I_PL + 2 * I_GT;
    for (int it = gw; it < NITEMS; it += NGW) {
        int r = it;
        if (r < I_IN) { p0_transpose_item(F.in[3], F.in[2], D, 4096, WIN, 0, scr, r, F.lane); continue; } r -= I_IN;
        if (r < I_OA) { p0_transpose_item(F.in[4], nullptr, D, D, WOA, 0, scr, r, F.lane); continue; } r -= I_OA;
        if (r < I_KV) { p0_transpose_item(F.in[6], F.in[5], D, 2048, WKVQ, 0, scr, r, F.lane); continue; } r -= I_KV;
        if (r < I_QB) { p0_transpose_item(F.in[7], F.in[2] + D, D, 2048, WKVQ, 2048, scr, r, F.lane); continue; } r -= I_QB;
        if (r < I_OB) { p0_transpose_item(F.in[10], nullptr, D, D, WOB, 0, scr, r, F.lane); continue; } r -= I_OB;
        if (r < I_PL) { p0_transpose_item(F.in[13], nullptr, PLE_DIM, D, WPLE, 0, scr, r, F.lane); continue; } r -= I_PL;
        if (r < I_PL) { p0_transpose_item(F.in[13] + (size_t)PLE_DIM * D, nullptr, PLE_DIM, D, WPLE + (size_t)D * PLE_DIM, 0, scr, r, F.lane); continue; } r -= I_PL;
        if (r < I_GT) { p0_transpose_item(F.in[14], F.in[12], D, D, WG, 0, scr, r, F.lane); continue; } r -= I_GT;
        p0_transpose_item(F.in[14] + (size_t)D * D, F.in[12] + D, D, D, WG + (size_t)D * D, 0, scr, r, F.lane);
    }
    bf16* XN = (bf16*)(ws + WS_XN);
    for (int m = gw; m < M; m += NGW) rms_row_to_bf16(F.lane, F.in[0] + (size_t)m * D, XN + (size_t)m * D);
    const GAS f32x4* pp = (const GAS f32x4*)F.in[1]; GAS v4u* pb = (GAS v4u*)(ws + WS_PB);
    constexpr int NP8 = 2 * M * PLE_DIM / 8;
    for (int i = gw * 64 + F.lane; i < NP8; i += NGW * 64) { const f32x4 a = pp[2 * i], b = pp[2 * i + 1]; v4u o; o.x = pk2(a.x, a.y); o.y = pk2(a.z, a.w); o.z = pk2(b.x, b.y); o.w = pk2(b.z, b.w); pb[i] = o; }
}

constexpr int SB_WLDS = 9216;
DI void sb_task(const bf16* QKVG, bf16* OG, int b, int h, int qt, LAS char* wl, int lane) {
    const int r32 = lane & 31, hi = lane >> 5;
    const size_t rowbase = (size_t)b * SEQ;
    const size_t hb = ((size_t)(b * 16 + h) * SEQ) * 64;
    const bf16* Qp = QKVG + hb + (size_t)(32 * qt + r32) * 64 + 8 * hi;
    bf16x8 qf[4];
#pragma unroll
    for (int d0 = 0; d0 < 4; ++d0) qf[d0] = *(const GAS bf16x8*)(Qp + 16 * d0);
    f32x16 oT[2]; oT[0] = f32x16{}; oT[1] = f32x16{};
    float carry = 0.f;
    const unsigned himask = 0u - (unsigned)hi;
    LAS const char* vrd = wl + (4 * hi + ((lane & 15) >> 2)) * 192 + (16 * ((lane >> 4) & 1) + 4 * (lane & 3)) * 2;
    for (int kb = qt; kb >= 0; --kb) {
        const bf16* Kp = QKVG + ((size_t)1 << 24) + hb + (size_t)(32 * kb + r32) * 64 + 8 * hi;
        bf16x8 kf[4];
#pragma unroll
        for (int d0 = 0; d0 < 4; ++d0) kf[d0] = *(const GAS bf16x8*)(Kp + 16 * d0);
        v4u vv[4];
#pragma unroll
        for (int i = 0; i < 4; ++i) { const int c = lane + 64 * i, row = c >> 3, ch = c & 7; vv[i] = *(const GAS v4u*)(QKVG + ((size_t)2 << 24) + hb + (size_t)(32 * kb + row) * 64 + ch * 8); }
        f32x16 z = f32x16{};
#pragma unroll
        for (int d0 = 0; d0 < 4; ++d0) z = MFMA32(kf[d0], qf[d0], z);
#pragma unroll
        for (int i = 0; i < 4; ++i) { const int c = lane + 64 * i, row = c >> 3, ch = c & 7; *(LAS v4u*)(wl + row * 192 + ch * 16) = vv[i]; }
        float nl[16], ls[16];
#pragma unroll
        for (int r = 0; r < 16; ++r) { const float zz = z[r]; const float e = __builtin_amdgcn_exp2f(-fabsf(zz)); const float lg = __builtin_amdgcn_logf(1.f + e);
            nl[r] = -(fmaxf(zz, 0.f) + lg); ls[r] = fminf(zz, 0.f) - lg; }
        const bool diag = (kb == qt);
        if (diag) {
#pragma unroll
            for (int r = 0; r < 16; ++r) if (crow(r, hi) >= r32) { nl[r] = 0.f; ls[r] = -INFINITY; }
        }
        float ga[4], gb[4];
#pragma unroll
        for (int g = 0; g < 4; ++g) { const float gs = (nl[4 * g] + nl[4 * g + 1]) + (nl[4 * g + 2] + nl[4 * g + 3]);
            auto rr = __builtin_amdgcn_permlane32_swap(__float_as_uint(gs), __float_as_uint(gs), false, false); ga[g] = __uint_as_float(rr[0]); gb[g] = __uint_as_float(rr[1]); }
        float T[8]; T[7] = 0.f; T[6] = gb[3]; T[5] = T[6] + ga[3]; T[4] = T[5] + gb[2]; T[3] = T[4] + ga[2]; T[2] = T[3] + gb[1]; T[1] = T[2] + ga[1]; T[0] = T[1] + gb[0];
        const float total = T[0] + ga[0];
        float w[16];
#pragma unroll
        for (int g = 0; g < 4; ++g) { const float tsel = __uint_as_float((__float_as_uint(T[2 * g]) & ~himask) | (__float_as_uint(T[2 * g + 1]) & himask));
            const float a3 = carry + tsel, a2 = a3 + nl[4 * g + 3], a1 = a2 + nl[4 * g + 2], a0 = a1 + nl[4 * g + 1];
            w[4 * g + 3] = __builtin_amdgcn_exp2f(ls[4 * g + 3] + a3); w[4 * g + 2] = __builtin_amdgcn_exp2f(ls[4 * g + 2] + a2);
            w[4 * g + 1] = __builtin_amdgcn_exp2f(ls[4 * g + 1] + a1); w[4 * g + 0] = __builtin_amdgcn_exp2f(ls[4 * g + 0] + a0); }
        carry += total;
        asm volatile("" ::: "memory");
#pragma unroll
        for (int s = 0; s < 2; ++s) {
            v4u pw; pw.x = cvtpk(w[8 * s], w[8 * s + 1]); pw.y = cvtpk(w[8 * s + 2], w[8 * s + 3]); pw.z = cvtpk(w[8 * s + 4], w[8 * s + 5]); pw.w = cvtpk(w[8 * s + 6], w[8 * s + 7]);
            const bf16x8 wf = __builtin_bit_cast(bf16x8, pw);
#pragma unroll
            for (int db = 0; db < 2; ++db) {
                const s16x4 lo = vtr(vrd + (16 * s) * 192 + db * 64), hh = vtr(vrd + (16 * s + 8) * 192 + db * 64);
                const bf16x8 vf = (bf16x8){lo[0], lo[1], lo[2], lo[3], hh[0], hh[1], hh[2], hh[3]};
                oT[db] = MFMA32(vf, wf, oT[db]);
            }
        }
        asm volatile("" ::: "memory");
        if (__all(carry < -151.f)) break;
    }
#pragma unroll
    for (int db = 0; db < 2; ++db)
#pragma unroll
        for (int g = 0; g < 4; ++g) *(LAS f32x4*)(wl + r32 * 272 + (32 * db + 8 * g + 4 * hi) * 4) = (f32x4){oT[db][4 * g], oT[db][4 * g + 1], oT[db][4 * g + 2], oT[db][4 * g + 3]};
    asm volatile("" ::: "memory");
#pragma unroll
    for (int i = 0; i < 4; ++i) { const int c = lane + 64 * i, row = c >> 3, ch = c & 7;
        const f32x4 a = *(LAS const f32x4*)(wl + row * 272 + ch * 32), bq = *(LAS const f32x4*)(wl + row * 272 + ch * 32 + 16);
        const v4u gw = *(const GAS v4u*)(QKVG + ((size_t)3 << 24) + (rowbase + 32 * qt + row) * D + h * 64 + ch * 8);
        v4u o; o.x = cvtpk(a[0] * siluf_(bflo(gw.x)), a[1] * siluf_(bfhi(gw.x))); o.y = cvtpk(a[2] * siluf_(bflo(gw.y)), a[3] * siluf_(bfhi(gw.y)));
        o.z = cvtpk(bq[0] * siluf_(bflo(gw.z)), bq[1] * siluf_(bfhi(gw.z))); o.w = cvtpk(bq[2] * siluf_(bflo(gw.w)), bq[3] * siluf_(bfhi(gw.w)));
        *(GAS v4u*)(OG + (rowbase + 32 * qt + row) * D + h * 64 + ch * 8) = o; }
    asm volatile("" ::: "memory");
}
DI void sb_phase(Frame& F) {
    const bf16* QKVG = (const bf16*)(F.ws + WS_QKVG); bf16* OG = (bf16*)(F.ws + WS_OG);
    LAS char* wl = (LAS char*)F.lds + RING_OFF + F.wave * SB_WLDS;
    const int gw = F.vcu * NWAVES + F.wave, NGW = F.G * NWAVES;
    constexpr int NTASK = BATCH * 16 * (SEQ / 32);
    const int ln = lane_now();
    for (int t = gw; t < NTASK; t += NGW) { const int qt = t & 255, bh = t >> 8; sb_task(QKVG, OG, bh >> 4, bh & 15, qt, wl, ln); }
}

constexpr int DA_PD = 3, DA_NS = 4;
static_assert(102400 + 8 * 4096 <= LDSCTL_OFF, "LDS map");
constexpr int DA_Q = 102400;
constexpr int DA_K = 0, DA_V = 32768, DA_TBL = 98304, DA_SUB = DA_TBL + 640 * 4, DA_STG = 0  , DA_WSTG = 8704;
constexpr int DA_THR = 8;
#define SBAR() __builtin_amdgcn_sched_barrier(0)
DI void glds16(const void* sbase, unsigned voff, unsigned lds_dst) { unsigned keep;
    asm volatile("s_mov_b32 %0, m0\n\ts_mov_b32 m0, %3\n\ts_nop 0\n\tglobal_load_lds_dwordx4 %1, %2\n\ts_mov_b32 m0, %0" : "=&s"(keep) : "v"(voff), "s"(sbase), "s"(lds_dst) : "memory"); }
#define WAIT_BAR_ALL() asm volatile("s_waitcnt vmcnt(0) lgkmcnt(0)\n\ts_barrier" ::: "memory")
#define WAIT_BAR_N(N) asm volatile("s_waitcnt vmcnt(" #N ") lgkmcnt(0)\n\ts_barrier" ::: "memory")
DI int t5_bucket(int n) {
    if (n < 16) return n;
    int b = 16;
    b += (n >= 19); b += (n >= 21); b += (n >= 24); b += (n >= 27); b += (n >= 31); b += (n >= 35); b += (n >= 40); b += (n >= 46);
    b += (n >= 52); b += (n >= 59); b += (n >= 67); b += (n >= 77); b += (n >= 87); b += (n >= 99); b += (n >= 113);
    return b;
}
DI bf16x8 vfrag(LAS const char* p) { const s16x4 lo = vtr(p), hh = vtr(p + 512); return (bf16x8){lo[0], lo[1], lo[2], lo[3], hh[0], hh[1], hh[2], hh[3]}; }
DI float max3f(float a, float b, float c) { float r; asm("v_max3_f32 %0, %1, %2, %3" : "=v"(r) : "v"(a), "v"(b), "v"(c)); return r; }
template <bool HAS_A, bool HAS_B, bool FIRST>
DI void da_step(f32x16 (&oT)[4], LAS const char* qp, v4u (&pw)[4], float& mhat, float& lsum, float& fpend, LAS const char* kp, int kq, LAS const char* vp, LAS const char* tb, int dbase, bool band, float c31) {
    f32x16 c0, c1; bf16x8 kf[8], vf[8], qf[4]; v4u pwn[4];
    if (HAS_A) {
#pragma unroll
        for (int d0 = 0; d0 < 4; ++d0) qf[d0] = *(LAS const bf16x8*)(qp + d0 * 1024);
#pragma unroll
        for (int i = 0; i < 8; ++i) kf[i] = *(LAS const bf16x8*)(kp + (kq ^ ((i >> 1) * 32)) + (i & 1) * 4096);
    }
    if (HAS_B && !HAS_A) {
#pragma unroll
        for (int i = 0; i < 8; ++i) vf[i] = vfrag(vp + (i & 3) * 4096 + (i >> 2) * 1024);
    }
    if (HAS_B && __any(fpend != 1.f)) {
#pragma unroll
        for (int db = 0; db < 4; ++db)
#pragma unroll
            for (int r = 0; r < 16; ++r) oT[db][r] *= fpend;
    }
    fpend = 1.f;
    SBAR();
    if (HAS_A) {
        { const float ini = c31 - mhat;
#pragma unroll
          for (int r = 0; r < 16; ++r) { c0[r] = ini; c1[r] = ini; } }
#pragma unroll
        for (int i = 0; i < 8; ++i) { const int d0 = i >> 1;
            if (i & 1) c1 = MFMA32(kf[i], qf[d0], c1); else c0 = MFMA32(kf[i], qf[d0], c0);
            if (HAS_B) vf[i] = vfrag(vp + (i & 3) * 4096 + (i >> 2) * 1024);
            SBAR(); }
        if (band) {
            float bb0[16], bb1[16];
#pragma unroll
            for (int r = 0; r < 16; ++r) { const int k = (r & 3) + 8 * (r >> 2); bb0[r] = *(LAS const float*)(tb + (59 - k) * 4); bb1[r] = *(LAS const float*)(tb + (27 - k) * 4); }
            asm volatile("" : "+v"(bb0[0]), "+v"(bb0[1]), "+v"(bb0[2]), "+v"(bb0[3]), "+v"(bb0[4]), "+v"(bb0[5]), "+v"(bb0[6]), "+v"(bb0[7]), "+v"(bb0[8]), "+v"(bb0[9]), "+v"(bb0[10]), "+v"(bb0[11]), "+v"(bb0[12]), "+v"(bb0[13]), "+v"(bb0[14]), "+v"(bb0[15]));
            asm volatile("" : "+v"(bb1[0]), "+v"(bb1[1]), "+v"(bb1[2]), "+v"(bb1[3]), "+v"(bb1[4]), "+v"(bb1[5]), "+v"(bb1[6]), "+v"(bb1[7]), "+v"(bb1[8]), "+v"(bb1[9]), "+v"(bb1[10]), "+v"(bb1[11]), "+v"(bb1[12]), "+v"(bb1[13]), "+v"(bb1[14]), "+v"(bb1[15]));
#pragma unroll
            for (int r = 0; r < 16; ++r) { const int k = (r & 3) + 8 * (r >> 2);
                c0[r] = (dbase - k >= 0) ? c0[r] + bb0[r] : -INFINITY; c1[r] = (dbase - k - 32 >= 0) ? c1[r] + bb1[r] : -INFINITY; }
        }
        float a = max3f(c0[0], c0[1], c1[0]), b = max3f(c0[2], c0[3], c1[1]); a = max3f(a, c1[2], c1[3]);
#pragma unroll
        for (int r = 4; r < 16; r += 4) { a = max3f(a, c0[r], c0[r + 1]); b = max3f(b, c0[r + 2], c0[r + 3]); a = max3f(a, c1[r], c1[r + 1]); b = max3f(b, c1[r + 2], c1[r + 3]); }
        const float rm = swap_max(max3f(a, b, b));
        if (FIRST || __any(rm > (float)DA_THR)) {
            const float dl = FIRST ? rm : fmaxf(rm, 0.f);
            mhat += dl; const float f = __builtin_amdgcn_exp2f(-dl); lsum *= f; if (!FIRST) fpend = f;
#pragma unroll
            for (int r = 0; r < 16; ++r) { c0[r] -= dl; c1[r] -= dl; }
        }
    }
    SBAR();
    f32x2_t ps2 = {0.f, 0.f};
#pragma unroll
    for (int j = 0; j < 16; ++j) {
        if (HAS_B) { const int ks = j >> 2, db = j & 3;
            oT[db] = MFMA32(vf[j & 7], __builtin_bit_cast(bf16x8, pw[ks]), oT[db]);
        }
        if (HAS_B && j < 8) vf[j] = vfrag(vp + (j & 3) * 4096 + (2 + (j >> 2)) * 1024);
        if (HAS_A) {
            f32x2_t e;
            if (j < 8) { e.x = __builtin_amdgcn_exp2f(c0[2 * j]); e.y = __builtin_amdgcn_exp2f(c0[2 * j + 1]); }
            else { e.x = __builtin_amdgcn_exp2f(c1[2 * j - 16]); e.y = __builtin_amdgcn_exp2f(c1[2 * j - 15]); }
            ps2 += e; unsigned pk = cvtpk(e.x, e.y);
            asm volatile("" : "+v"(pk), "+v"(ps2));
            pwn[j >> 2][j & 3] = pk;
        }
        SBAR();
    }
    if (HAS_A) { lsum += ps2.x + ps2.y;
#pragma unroll
        for (int k = 0; k < 4; ++k) pw[k] = pwn[k]; }
}
DI void da_epilogue(Frame& F, f32x16 (&oT)[4], float rl, int mp, const bf16* KVQG, bf16* OG, float* scr, size_t row0, int h, LAS char* lds) {
    const int tid = tid_now(), lane = tid & 63, wid = tid >> 6, r32 = lane & 31, hi = lane >> 5;
    LAS float* subl = (LAS float*)(lds + DA_SUB);
    GAS f32x4* myscr = (GAS f32x4*)(scr + ((size_t)(blockIdx.x * NWAVES + wid) * 64 + lane) * 64);
    if (mp == 0) {
#pragma unroll
        for (int db = 0; db < 4; ++db)
#pragma unroll
            for (int g = 0; g < 4; ++g) myscr[db * 4 + g] = (f32x4){oT[db][4 * g] * rl, oT[db][4 * g + 1] * rl, oT[db][4 * g + 2] * rl, oT[db][4 * g + 3] * rl};
    } else {
        float lam;
        { const float* lp = F.in[8]; float s1 = 0.f, s2 = 0.f;
          for (int i = 0; i < 64; ++i) { s1 += lp[i] * lp[64 + i]; s2 += lp[128 + i] * lp[192 + i]; }
          lam = expf(s1) - expf(s2) + LAM_INIT; }
        float ss = 0.f;
#pragma unroll
        for (int db = 0; db < 4; ++db)
#pragma unroll
            for (int g = 0; g < 4; ++g) { const f32x4 o1 = myscr[db * 4 + g];
#pragma unroll
                for (int j = 0; j < 4; ++j) { const float o = o1[j] - lam * (oT[db][4 * g + j] * rl); oT[db][4 * g + j] = o; ss += o * o; } }
        const float rn = 1.f / sqrtf(swap_sum(ss) * (1.f / 128.f) + EPS);
        LAS char* stg = lds + DA_STG + wid * DA_WSTG;
#pragma unroll
        for (int hh = 0; hh < 2; ++hh) {
#pragma unroll
            for (int dd = 0; dd < 2; ++dd)
#pragma unroll
                for (int g = 0; g < 4; ++g) { const int db = 2 * hh + dd; const f32x4 sg = *(LAS const f32x4*)(subl + 32 * db + 8 * g + 4 * hi);
                    *(LAS f32x4*)(stg + r32 * 272 + (32 * dd + 8 * g + 4 * hi) * 4) = (f32x4){oT[db][4 * g] * rn * sg[0], oT[db][4 * g + 1] * rn * sg[1], oT[db][4 * g + 2] * rn * sg[2], oT[db][4 * g + 3] * rn * sg[3]}; }
            asm volatile("" ::: "memory");
#pragma unroll
            for (int i = 0; i < 4; ++i) { const int c = lane + 64 * i, row = c >> 3, ch = c & 7;
                const f32x4 a = *(LAS const f32x4*)(stg + row * 272 + ch * 32), bq = *(LAS const f32x4*)(stg + row * 272 + ch * 32 + 16);
                const v4u gw = *(const GAS v4u*)(KVQG + ((size_t)3 << 24) + (row0 + row) * D + h * 128 + 64 * hh + ch * 8);
                v4u o; o.x = cvtpk(a[0] * siluf_(bflo(gw.x)), a[1] * siluf_(bfhi(gw.x))); o.y = cvtpk(a[2] * siluf_(bflo(gw.y)), a[3] * siluf_(bfhi(gw.y)));
                o.z = cvtpk(bq[0] * siluf_(bflo(gw.z)), bq[1] * siluf_(bfhi(gw.z))); o.w = cvtpk(bq[2] * siluf_(bflo(gw.w)), bq[3] * siluf_(bfhi(gw.w)));
                *(GAS v4u*)(OG + (row0 + row) * D + h * 128 + 64 * hh + ch * 8) = o; }
            asm volatile("" ::: "memory");
        }
    }
}
DI void da_unit(Frame& F, const bf16* KVQG, bf16* OG, float* scr, int b, int h, int qb) {
    LAS char* lds = (LAS char*)F.lds + RING_OFF;
    const int tid = tid_now(), lane = tid & 63, wid = F.wave, r32 = lane & 31, hi = lane >> 5;
    const size_t rowbase = (size_t)b * SEQ; const int q0 = qb * 256, qw0 = q0 + 32 * wid;
    const float* rb = F.in[11];
    const float c31 = rb[31 * 8 + h] * LOG2E;
    LAS float* tbl = (LAS float*)(lds + DA_TBL); LAS float* subl = (LAS float*)(lds + DA_SUB);
    __syncthreads();
    for (int i = tid; i < 640; i += 512) { const int dist = i - 256; tbl[i] = dist < 0 ? 0.f : rb[t5_bucket(dist) * 8 + h] * LOG2E - c31; }
    if (tid < 128) subl[tid] = F.in[9][tid] * (1.f - LAM_INIT);
    const int NT = 4 * qb + 4, NTw = (qw0 >> 6) + 1;
    const int kx = r32 & 7;
    LAS const char* kp0 = lds + DA_K + r32 * 128;
    LAS const char* vp0 = lds + DA_V + ((lane >> 4) & 1) * 32 + (lane & 3) * 8 + (4 * hi + ((lane & 15) >> 2)) * 64;
    const unsigned kdst = (unsigned)(size_t)(lds + DA_K) + wid * 1024, vdst = (unsigned)(size_t)(lds + DA_V) + wid * 1024;
#pragma unroll 1
    for (int mp = 0; mp < 2; ++mp) {
        const size_t hb64 = ((size_t)(b * 8 + h) * SEQ) * 64, hb128 = ((size_t)(b * 8 + h) * SEQ) * 128;
        const unsigned koff = (unsigned)((((size_t)mp << 23) + hb64 + (size_t)(8 * wid + (lane >> 3)) * 64 + (((lane & 7) ^ ((lane >> 3) & 7)) * 8)) * 2);
        const unsigned voff = (unsigned)((((size_t)1 << 24) + hb128 + (size_t)(16 * (wid & 3) + (lane >> 2)) * 128 + 32 * (wid >> 2) + 8 * (lane & 3)) * 2);
        __syncthreads();
#define DA_ISSUE(tt) do { const int kt_ = ((tt) + DA_PD < NT) ? (tt) + DA_PD : NT - 1; int vt_ = (tt) + DA_PD - 1; vt_ = vt_ < 0 ? 0 : (vt_ < NT ? vt_ : NT - 1); \
            glds16(KVQG, koff + (unsigned)kt_ * 8192u, (unsigned)__builtin_amdgcn_readfirstlane(kdst + (((tt) + DA_PD) & 3) * 8192)); \
            const unsigned vs_ = voff + (unsigned)vt_ * 16384u; const unsigned vd_ = (unsigned)__builtin_amdgcn_readfirstlane(vdst + (((tt) + DA_PD - 1) & 3) * 16384); glds16(KVQG, vs_, vd_); glds16(KVQG, vs_ + 128u, vd_ + 8192); } while (0)
        DA_ISSUE(-3); DA_ISSUE(-2); DA_ISSUE(-1);
        bf16x8 qf[4];
        { const bf16* Qp = KVQG + ((size_t)2 << 24) + ((size_t)mp << 23) + hb64 + (size_t)(qw0 + r32) * 64 + 8 * hi;
#pragma unroll
          for (int d0 = 0; d0 < 4; ++d0) qf[d0] = *(const GAS bf16x8*)(Qp + 16 * d0); }
        LAS char* qp = lds + DA_Q + wid * 4096 + lane * 16;
#pragma unroll
        for (int d0 = 0; d0 < 4; ++d0) *(LAS bf16x8*)(qp + d0 * 1024) = qf[d0];
        f32x16 oT[4]; oT[0] = f32x16{}; oT[1] = f32x16{}; oT[2] = f32x16{}; oT[3] = f32x16{};
        v4u pw[4]; pw[0] = v4u{}; pw[1] = v4u{}; pw[2] = v4u{}; pw[3] = v4u{};
        float mhat = 0.f, lsum = 0.f;
        WAIT_BAR_N(6);
        float fpend = 1.f;
        const int kq = ((hi ^ kx) & 1) * 16 + (kx >> 1) * 32;
#define DA_ADDR(t) LAS const char* kp = kp0 + ((t) & 3) * 8192; LAS const char* vp = vp0 + (((t) + 3) & 3) * 16384; const int kv0 = 64 * (t); const bool band = (qw0 - (kv0 + 63)) < 113; \
            const int dbase = qw0 + r32 - kv0 - 4 * hi; LAS const char* tb = (LAS const char*)tbl + (dbase + 256 - 59) * 4
        { DA_ISSUE(0); DA_ADDR(0); da_step<true, false, true>(oT, qp, pw, mhat, lsum, fpend, kp, kq, vp, tb, dbase, band, c31); WAIT_BAR_N(6); }
#pragma unroll 1
        for (int t = 1; t < NTw; ++t) { DA_ISSUE(t); DA_ADDR(t); da_step<true, true, false>(oT, qp, pw, mhat, lsum, fpend, kp, kq, vp, tb, dbase, band, c31); WAIT_BAR_N(6); }
        { const int t = NTw; DA_ISSUE(t); DA_ADDR(t); (void)band; da_step<false, true, false>(oT, qp, pw, mhat, lsum, fpend, kp, kq, vp, tb, dbase, false, c31); WAIT_BAR_N(6); }
#pragma unroll 1
        for (int t = NTw + 1; t <= NT; ++t) { DA_ISSUE(t); WAIT_BAR_N(6); }
#undef DA_ADDR
        WAIT_BAR_ALL();
#undef DA_ISSUE
        da_epilogue(F, oT, 1.f / swap_sum(lsum), mp, KVQG, OG, scr, rowbase + qw0, h, lds);
    }
}
DI void da_phase(Frame& F) {
    const bf16* KVQG = (const bf16*)(F.ws + WS_QKVG); bf16* OG = (bf16*)(F.ws + WS_OG); float* scr = (float*)(F.ws + WS_XN);
    for (int v = F.vcu; v < 256; v += F.G) {
        const int bh = v >> 4, s = v & 15;
#pragma unroll 1
        for (int k = 0; k < 2; ++k) da_unit(F, KVQG, OG, scr, bh >> 3, bh & 7, k ? 31 - s : s);
    }
}

constexpr int NPHASE = 13;
struct Args { const float* in[16]; float* out; unsigned char* ws; int ph_lo, ph_hi, li, pad; };
__global__ void __launch_bounds__(NWAVES * 64, 2) yoco_fwd(Args args) {
    extern __shared__ __attribute__((aligned(16))) unsigned char lds[];
    Frame F;
    F.lds = (LAS unsigned char*)lds;
    F.MISC = (volatile LAS unsigned*)(F.lds + MISC_OFF);
    F.tid = 0; F.lane = 0; F.wave = __builtin_amdgcn_readfirstlane((int)threadIdx.x >> 6);
    F.G = gridDim.x; { const int bx = blockIdx.x; F.vcu = (F.G % 8 == 0) ? (bx % 8) * (F.G / 8) + bx / 8 : bx; }
    unsigned char* ws = args.ws; F.ws = ws; F.out = args.out;
#pragma unroll
    for (int i = 0; i < 16; ++i) F.in[i] = args.in[i];
    F.ctl = (gu32*)(ws + WS_CTL);
    for (int u = threadIdx.x; u < (LDS_BYTES - LDSCTL_OFF) / 4; u += NWAVES * 64) ((LAS unsigned*)(F.lds + LDSCTL_OFF))[u] = 0u;
    __syncthreads();
    const int lo = args.ph_lo, hi = args.ph_hi;
    const bool multi = (hi - lo) > 1;
    XcdBarrier bar; bar.bar = (unsigned*)(F.ctl + CW_BAR) + args.li * XCD_BAR_WORDS; bar.x = 0; bar.st = nullptr;
    if (multi) bar = xcd_barrier_post((unsigned*)(F.ctl + CW_BAR) + args.li * XCD_BAR_WORDS, F.MISC + 8);
#ifndef PH_MASK
#define PH_MASK 0xFFFF
#endif
#define IN(k) (((PH_MASK >> (k)) & 1) && lo <= (k) && (k) < hi)
#define SEAM(k) do { if (IN(k) && IN((k) + 1)) xcd_barrier(bar); } while (0)
    bf16* XN = (bf16*)(ws + WS_XN); bf16* OG = (bf16*)(ws + WS_OG); bf16* QKVG = (bf16*)(ws + WS_QKVG); bf16* PLE = (bf16*)(ws + WS_PLE); bf16* PB = (bf16*)(ws + WS_PB);
    const int gw = F.vcu * NWAVES + F.wave, NGW = F.G * NWAVES;

    if (IN(0)) { p0_prologue(F); } SEAM(0);
    if (IN(1)) {
        pg8::Gemm g{XN, (const bf16*)(ws + WS_WIN), M, NQ4, D}; pg8::StaticOrder S; S.init(M, NQ4, F.G, (int)blockIdx.x);
        pg8::EpiProj E{QKVG, 0, C2};
        pg8::gemm_phase<pg8::EpiProj, pg8::StaticOrder, true, true>(F.lds + RING_OFF, g, S, E);
    } SEAM(1);
#ifndef REP2
#define REP2 1
#endif
    if (IN(2)) { for (int rep_ = 0; rep_ < REP2; ++rep_) { sb_phase(F); if (rep_ + 1 < REP2) xcd_barrier(bar); } } SEAM(2);
    if (IN(3)) {
        pg8::Gemm g{OG, (const bf16*)(ws + WS_WOA), M, D, D}; pg8::StaticOrder S; S.init(M, D, F.G, (int)blockIdx.x);
        pg8::EpiResF32 E{F.in[0], F.out, D};
        pg8::gemm_phase<pg8::EpiResF32, pg8::StaticOrder, true, true>(F.lds + RING_OFF, g, S, E);
    } SEAM(3);
    if (IN(4)) { const int ln = lane_now(); for (int m = gw; m < M; m += NGW) rms_row_to_bf16(ln, F.out + (size_t)m * D, XN + (size_t)m * D); } SEAM(4);
    if (IN(5)) {
        { pg8::Gemm g{PB, (const bf16*)(ws + WS_WPLE), M, D, PLE_DIM}; pg8::StaticOrder S; S.init(M, D, F.G, (int)blockIdx.x);
          pg8::EpiBf16NP E{PLE, D};
          pg8::gemm_phase<pg8::EpiBf16NP, pg8::StaticOrder, true, true>(F.lds + RING_OFF, g, S, E); }
        { pg8::Gemm g{XN, (const bf16*)(ws + WS_WG), M, D, D}; pg8::StaticOrder S; S.init(M, D, F.G, (int)blockIdx.x);
          pg8::EpiGate E{F.out, PLE, D};
          pg8::gemm_phase<pg8::EpiGate, pg8::StaticOrder, true, true>(F.lds + RING_OFF, g, S, E); }
    } SEAM(5);
    if (IN(6)) { const int ln = lane_now(); for (int m = gw; m < M; m += NGW) rms_row_to_bf16(ln, F.out + (size_t)m * D, XN + (size_t)m * D); } SEAM(6);
    if (IN(7)) {
        pg8::Gemm g{XN, (const bf16*)(ws + WS_WKVQ), M, NQ4, D}; pg8::StaticOrder S; S.init(M, NQ4, F.G, (int)blockIdx.x);
        pg8::EpiProj E{QKVG, 1, C2};
        pg8::gemm_phase<pg8::EpiProj, pg8::StaticOrder, true, true>(F.lds + RING_OFF, g, S, E);
    } SEAM(7);
#ifndef REP8
#define REP8 1
#endif
    if (IN(8)) { for (int rep_ = 0; rep_ < REP8; ++rep_) { da_phase(F); if (rep_ + 1 < REP8) xcd_barrier(bar); } } SEAM(8);
    if (IN(9)) {
        pg8::Gemm g{OG, (const bf16*)(ws + WS_WOB), M, D, D}; pg8::StaticOrder S; S.init(M, D, F.G, (int)blockIdx.x);
        pg8::EpiResF32 E{F.out, F.out, D};
        pg8::gemm_phase<pg8::EpiResF32, pg8::StaticOrder, true, true>(F.lds + RING_OFF, g, S, E);
    } SEAM(9);
    if (IN(10)) { const int ln = lane_now(); for (int m = gw; m < M; m += NGW) rms_row_to_bf16(ln, F.out + (size_t)m * D, XN + (size_t)m * D); } SEAM(10);
    if (IN(11)) {
        { pg8::Gemm g{PB + (size_t)M * PLE_DIM, (const bf16*)(ws + WS_WPLE) + (size_t)D * PLE_DIM, M, D, PLE_DIM}; pg8::StaticOrder S; S.init(M, D, F.G, (int)blockIdx.x);
          pg8::EpiBf16NP E{PLE, D};
          pg8::gemm_phase<pg8::EpiBf16NP, pg8::StaticOrder, true, true>(F.lds + RING_OFF, g, S, E); }
        { pg8::Gemm g{XN, (const bf16*)(ws + WS_WG) + (size_t)D * D, M, D, D}; pg8::StaticOrder S; S.init(M, D, F.G, (int)blockIdx.x);
          pg8::EpiGate E{F.out, PLE, D};
          pg8::gemm_phase<pg8::EpiGate, pg8::StaticOrder, true, true>(F.lds + RING_OFF, g, S, E); }
    } SEAM(11);
    if (IN(12)) { const int ln = lane_now(); for (int m = gw; m < M; m += NGW) rms_row_final(ln, F.out + (size_t)m * D, F.in[15], F.out + (size_t)m * D); }
#undef IN
#undef SEAM
}

#ifndef N_LAUNCHES
#define N_LAUNCHES 13
#endif
extern "C" void kernel_launch(void* const* d_in, const int* in_sizes, int n_in, void* d_out, int out_size, void* d_ws, size_t ws_size, hipStream_t stream) {
    static int grid = 0;
    if (grid == 0) {
        if (n_in != 16 || in_sizes[0] != M * D || out_size != M * D || ws_size < WS_END) { fprintf(stderr, "kernel_launch: unexpected shapes (n_in %d, in0 %d, out %d, ws %zu); nothing launched\n", n_in, n_in > 0 ? in_sizes[0] : -1, out_size, ws_size); grid = -1; return; }
        int dev = 0, cus = 0, per_cu = 0;
        if (hipGetDevice(&dev) != hipSuccess || hipDeviceGetAttribute(&cus, hipDeviceAttributeMultiprocessorCount, dev) != hipSuccess) { grid = -1; return; }
        if (hipFuncSetAttribute((const void*)yoco_fwd, hipFuncAttributeMaxDynamicSharedMemorySize, LDS_BYTES) != hipSuccess) { fprintf(stderr, "kernel_launch: hipFuncSetAttribute failed\n"); grid = -1; return; }
        if (hipOccupancyMaxActiveBlocksPerMultiprocessor(&per_cu, (const void*)yoco_fwd, NWAVES * 64, LDS_BYTES) != hipSuccess || per_cu < 1)
            fprintf(stderr, "kernel_launch: note: occupancy query reports %d workgroups per CU\n", per_cu);
        (void)hipGetLastError();
        grid = cus;
    }
    if (grid < 0) return;
    if (hipMemsetAsync((char*)d_ws + WS_CTL, 0, CTL_ZERO_BYTES, stream) != hipSuccess) { fprintf(stderr, "kernel_launch: hipMemsetAsync failed\n"); return; }
    Args a{};
    for (int i = 0; i < 16; ++i) a.in[i] = (const float*)d_in[i];
    a.out = (float*)d_out; a.ws = (unsigned char*)d_ws;
    for (int li = 0; li < N_LAUNCHES; ++li) {
        a.ph_lo = (N_LAUNCHES == 1) ? 0 : li; a.ph_hi = (N_LAUNCHES == 1) ? NPHASE : li + 1; a.li = 0;
        hipLaunchKernelGGL(yoco_fwd, dim3(grid), dim3(NWAVES * 64), LDS_BYTES, stream, a);
        const hipError_t le = hipPeekAtLastError();
        if (le != hipSuccess) { fprintf(stderr, "kernel_launch: launch %d failed: %s\n", li, hipGetErrorName(le)); break; }
    }
}
```
